# Optimizing an MI355X kernel written in HIP

```python
import jax, jax.numpy as jnp
from jax import lax
import numpy as np

D_MODEL = 2048
BATCH = 4
SEQ = 2048
DEPTH = 4

N_MIXERS = 2
EPS = 1e-6
D_FF = ((8 * D_MODEL // 3 + 127) // 128) * 128
ML_HEADS = 4
ML_QK_DIM = D_MODEL // (2 * ML_HEADS)
ML_V_DIM = D_MODEL // ML_HEADS
ML_QK_TOT = ML_HEADS * ML_QK_DIM
ML_V_TOT = ML_HEADS * ML_V_DIM
ML_IN = 2 * ML_QK_TOT + 2 * ML_V_TOT + 2 * ML_HEADS
ML_CHUNK = 64
GATE_SOFTCAP = 15.0
GDN_K_DIM = 128
GDN_V_DIM = 128
GDN_K_HEADS = D_MODEL // 128
GDN_V_HEADS = 2 * GDN_K_HEADS
GDN_K_TOT = GDN_K_HEADS * GDN_K_DIM
GDN_V_TOT = GDN_V_HEADS * GDN_V_DIM
GDN_CONV_CH = 2 * GDN_K_TOT + GDN_V_TOT
GDN_IN = GDN_CONV_CH + GDN_V_TOT + 2 * GDN_V_HEADS
GDN_CONV = 4
GDN_CHUNK = 64
N_ML_LAYERS = (DEPTH + 1) // 2
N_GDN_LAYERS = DEPTH // 2

kernel_name = "interleaved_mlstm_gdn_macaron_trunk"


def rms_norm(x, g):
    xf = x.astype(jnp.float32)
    y = xf * lax.rsqrt(jnp.mean(xf * xf, axis=-1, keepdims=True) + EPS)
    return (y * g.astype(jnp.float32)).astype(x.dtype)


def l2_norm(x):
    return x * lax.rsqrt(jnp.sum(x * x, axis=-1, keepdims=True) + EPS)


def softcap(x):
    return GATE_SOFTCAP * jnp.tanh(x / GATE_SOFTCAP)


def swiglu_ffn(x, w_in, w_out):
    gate, up = jnp.split(x @ w_in, 2, axis=-1)
    return (jax.nn.silu(gate) * up) @ w_out


def mlstm_chunkwise(q, k, v, i_pre, f_log):
    B, H, S, dqk = q.shape
    dv = v.shape[-1]
    L = ML_CHUNK
    NC = S // L

    def to_chunks(a):
        return jnp.moveaxis(a.reshape(B, H, NC, L, *a.shape[3:]), 2, 0)

    xs = tuple(to_chunks(a) for a in (q * (dqk ** -0.5), k, v, i_pre, f_log))
    causal = jnp.tril(jnp.ones((L, L), dtype=bool))

    def step(carry, inp):
        C, n, m = carry
        qb, kb, vb, ib, fb = inp
        b = jnp.cumsum(fb, axis=-1)
        log_d = jnp.where(causal, b[..., :, None] - b[..., None, :] + ib[..., None, :], -jnp.inf)
        log_inter = b + m[..., None]
        m_t = jnp.maximum(log_inter, jnp.max(log_d, axis=-1))
        d = jnp.exp(log_d - m_t[..., None])
        inter = jnp.exp(log_inter - m_t)
        s = jnp.einsum('bhld,bhsd->bhls', qb, kb) * d
        num = inter[..., None] * jnp.einsum('bhld,bhde->bhle', qb, C) + jnp.einsum('bhls,bhse->bhle', s, vb)
        den = inter * jnp.einsum('bhld,bhd->bhl', qb, n) + jnp.sum(s, axis=-1)
        h = num / jnp.maximum(jnp.abs(den), jnp.exp(-m_t))[..., None]
        b_last = b[..., -1]
        log_w = b_last[..., None] - b + ib
        m_new = jnp.maximum(b_last + m, jnp.max(log_w, axis=-1))
        w = jnp.exp(log_w - m_new[..., None])
        decay = jnp.exp(b_last + m - m_new)
        kw = kb * w[..., None]
        C_new = decay[..., None, None] * C + jnp.einsum('bhsd,bhse->bhde', kw, vb)
        n_new = decay[..., None] * n + jnp.sum(kw, axis=2)
        return (C_new, n_new, m_new), h

    init = (jnp.zeros((B, H, dqk, dv), q.dtype), jnp.zeros((B, H, dqk), q.dtype), jnp.zeros((B, H), q.dtype))
    _, hc = lax.scan(step, init, xs)
    return jnp.moveaxis(hc, 0, 2).reshape(B, H, S, dv)


def mlstm_mixer(x, w_in, i_bias, f_bias, head_g, w_out):
    B, S, _ = x.shape
    f32 = jnp.float32
    proj = x @ w_in
    q, k, v, o, i_pre, f_pre = jnp.split(
        proj, [ML_QK_TOT, 2 * ML_QK_TOT, 2 * ML_QK_TOT + ML_V_TOT, 2 * ML_QK_TOT + 2 * ML_V_TOT,
               2 * ML_QK_TOT + 2 * ML_V_TOT + ML_HEADS], axis=-1)

    def heads(a, d):
        return a.reshape(B, S, ML_HEADS, d).transpose(0, 2, 1, 3).astype(f32)

    i_log = softcap(i_pre.astype(f32) + i_bias.astype(f32)).transpose(0, 2, 1)
    f_log = jax.nn.log_sigmoid(softcap(f_pre.astype(f32) + f_bias.astype(f32))).transpose(0, 2, 1)
    h = mlstm_chunkwise(heads(q, ML_QK_DIM), heads(k, ML_QK_DIM), heads(v, ML_V_DIM), i_log, f_log)
    h = rms_norm(h.transpose(0, 2, 1, 3), head_g)
    y = jax.nn.sigmoid(o) * h.reshape(B, S, ML_V_TOT).astype(x.dtype)
    return y @ w_out


def causal_short_conv(x, w):
    S = x.shape[1]
    K = w.shape[0]
    xp = jnp.pad(x, ((0, 0), (K - 1, 0), (0, 0)))
    y = xp[:, 0:S] * w[0]
    for j in range(1, K):
        y = y + xp[:, j:j + S] * w[j]
    return y


def gated_delta_chunked(q, k, v, g, beta):
    B, S, H, dk = q.shape
    dv = v.shape[-1]
    L = GDN_CHUNK
    NC = S // L

    def chunks(a):
        a = jnp.moveaxis(a, 2, 1)
        return a.reshape(B, H, NC, L, *a.shape[3:])

    q, k, v, g, beta = (chunks(a) for a in (q, k, v, g, beta))
    g = jnp.cumsum(g, axis=-1)
    incl = jnp.tril(jnp.ones((L, L), dtype=bool))
    strict = jnp.tril(jnp.ones((L, L), dtype=bool), k=-1)
    decay = jnp.exp(jnp.where(incl, g[..., :, None] - g[..., None, :], -jnp.inf))
    kb = k * beta[..., None]
    vb = v * beta[..., None]
    a_low = jnp.where(strict, jnp.einsum('bhnld,bhnsd->bhnls', kb, k) * decay, 0.0)
    eye = jnp.eye(L, dtype=q.dtype)
    rhs = jnp.concatenate([vb, kb * jnp.exp(g)[..., None]], axis=-1)
    sol = lax.linalg.triangular_solve(eye + a_low, rhs, left_side=True, lower=True, unit_diagonal=True)
    u, w = sol[..., :dv], sol[..., dv:]
    qk = jnp.where(incl, jnp.einsum('bhnld,bhnsd->bhnls', q, k) * decay, 0.0)

    def step(state, inp):
        qb, kb_, ub, wb, gb, ab = inp
        v_new = ub - jnp.einsum('bhld,bhde->bhle', wb, state)
        out = jnp.einsum('bhld,bhde->bhle', qb * jnp.exp(gb)[..., None], state) + jnp.einsum('bhls,bhse->bhle', ab, v_new)
        g_last = gb[..., -1]
        k_dec = kb_ * jnp.exp(g_last[..., None] - gb)[..., None]
        state = state * jnp.exp(g_last)[..., None, None] + jnp.einsum('bhld,bhle->bhde', k_dec, v_new)
        return state, out

    xs = tuple(jnp.moveaxis(a, 2, 0) for a in (q, k, u, w, g, qk))
    _, out = lax.scan(step, jnp.zeros((B, H, dk, dv), q.dtype), xs)
    out = jnp.moveaxis(out, 0, 2).reshape(B, H, S, dv)
    return jnp.moveaxis(out, 1, 2)


def gdn_mixer(x, w_in, conv_w, a_log, dt_bias, norm_g, w_out):
    B, S, _ = x.shape
    f32 = jnp.float32
    proj = x @ w_in
    qkv, z, b_pre, a_pre = jnp.split(proj, [GDN_CONV_CH, GDN_CONV_CH + GDN_V_TOT, GDN_CONV_CH + GDN_V_TOT + GDN_V_HEADS], axis=-1)
    qkv = jax.nn.silu(causal_short_conv(qkv, conv_w))
    q, k, v = jnp.split(qkv, [GDN_K_TOT, 2 * GDN_K_TOT], axis=-1)
    q = l2_norm(q.reshape(B, S, GDN_K_HEADS, GDN_K_DIM).astype(f32)) * (GDN_K_DIM ** -0.5)
    k = l2_norm(k.reshape(B, S, GDN_K_HEADS, GDN_K_DIM).astype(f32))
    rep = GDN_V_HEADS // GDN_K_HEADS
    q = jnp.repeat(q, rep, axis=2)
    k = jnp.repeat(k, rep, axis=2)
    v = v.reshape(B, S, GDN_V_HEADS, GDN_V_DIM).astype(f32)
    beta = jax.nn.sigmoid(b_pre.astype(f32))
    g = -jnp.exp(a_log.astype(f32)) * jax.nn.softplus(a_pre.astype(f32) + dt_bias.astype(f32))
    o = gated_delta_chunked(q, k, v, g, beta)
    o = rms_norm(o, norm_g).astype(x.dtype) * jax.nn.silu(z.reshape(B, S, GDN_V_HEADS, GDN_V_DIM))
    return o.reshape(B, S, GDN_V_TOT) @ w_out


def setup_inputs(seed: int = 0) -> dict:
    key = jax.random.key(seed)
    ks = jax.random.split(key, 16)
    nrm = jax.random.normal
    x = nrm(ks[0], (BATCH, SEQ, D_MODEL), jnp.float32)
    norm_g = 1.0 + 0.02 * nrm(ks[1], (DEPTH, 6, D_MODEL), jnp.float32)
    ffn_w_in = nrm(ks[2], (DEPTH, 2, D_MODEL, 2 * D_FF), jnp.float32) * D_MODEL ** -0.5
    ffn_w_out = nrm(ks[3], (DEPTH, 2, D_FF, D_MODEL), jnp.float32) * D_FF ** -0.5
    ml_w_in = nrm(ks[4], (N_ML_LAYERS, D_MODEL, ML_IN), jnp.float32) * D_MODEL ** -0.5
    ml_i_bias = 0.1 * nrm(ks[5], (N_ML_LAYERS, ML_HEADS), jnp.float32)
    ml_f_bias = 3.0 + 3.0 * jax.random.uniform(ks[6], (N_ML_LAYERS, ML_HEADS), jnp.float32)
    ml_head_g = 1.0 + 0.02 * nrm(ks[7], (N_ML_LAYERS, ML_HEADS, ML_V_DIM), jnp.float32)
    ml_w_out = nrm(ks[8], (N_ML_LAYERS, ML_V_TOT, D_MODEL), jnp.float32) * ML_V_TOT ** -0.5
    gdn_w_in = nrm(ks[9], (N_GDN_LAYERS, D_MODEL, GDN_IN), jnp.float32) * D_MODEL ** -0.5
    gdn_conv_w = nrm(ks[10], (N_GDN_LAYERS, GDN_CONV, GDN_CONV_CH), jnp.float32) * GDN_CONV ** -0.5
    gdn_a_log = jnp.log(jax.random.uniform(ks[11], (N_GDN_LAYERS, GDN_V_HEADS), jnp.float32, 1.0, 16.0))
    dt = jnp.exp(jax.random.uniform(ks[12], (N_GDN_LAYERS, GDN_V_HEADS), jnp.float32, jnp.log(0.001), jnp.log(0.1)))
    gdn_dt_bias = dt + jnp.log(-jnp.expm1(-dt))
    gdn_norm_g = 1.0 + 0.02 * nrm(ks[13], (N_GDN_LAYERS, GDN_V_DIM), jnp.float32)
    gdn_w_out = nrm(ks[14], (N_GDN_LAYERS, GDN_V_TOT, D_MODEL), jnp.float32) * GDN_V_TOT ** -0.5
    return {"x": x, "norm_g": norm_g, "ffn_w_in": ffn_w_in, "ffn_w_out": ffn_w_out,
            "ml_w_in": ml_w_in, "ml_i_bias": ml_i_bias, "ml_f_bias": ml_f_bias, "ml_head_g": ml_head_g,
            "ml_w_out": ml_w_out, "gdn_w_in": gdn_w_in, "gdn_conv_w": gdn_conv_w, "gdn_a_log": gdn_a_log,
            "gdn_dt_bias": gdn_dt_bias, "gdn_norm_g": gdn_norm_g, "gdn_w_out": gdn_w_out}


def reference(x, norm_g, ffn_w_in, ffn_w_out, ml_w_in, ml_i_bias, ml_f_bias, ml_head_g, ml_w_out,
              gdn_w_in, gdn_conv_w, gdn_a_log, gdn_dt_bias, gdn_norm_g, gdn_w_out):
    h = x
    for layer in range(DEPTH):
        g = norm_g[layer]
        h = h + 0.5 * rms_norm(swiglu_ffn(rms_norm(h, g[0]), ffn_w_in[layer, 0], ffn_w_out[layer, 0]), g[1])
        j = layer // N_MIXERS
        hn = rms_norm(h, g[2])
        if layer % N_MIXERS == 0:
            mix = mlstm_mixer(hn, ml_w_in[j], ml_i_bias[j], ml_f_bias[j], ml_head_g[j], ml_w_out[j])
        else:
            mix = gdn_mixer(hn, gdn_w_in[j], gdn_conv_w[j], gdn_a_log[j], gdn_dt_bias[j], gdn_norm_g[j], gdn_w_out[j])
        h = h + rms_norm(mix, g[3])
        h = h + 0.5 * rms_norm(swiglu_ffn(rms_norm(h, g[4]), ffn_w_in[layer, 1], ffn_w_out[layer, 1]), g[5])
    return h
```

```cpp
#include <hip/hip_runtime.h>
#include <cstdio>
#include <cstdint>
namespace pg8 {
#define PG8_LAS __attribute__((address_space(3)))
typedef unsigned short bf16_t;
typedef short bf16x8 __attribute__((ext_vector_type(8)));
typedef float f32x4 __attribute__((ext_vector_type(4)));
typedef unsigned u32x4 __attribute__((ext_vector_type(4)));
constexpr int BM = 256, BK = 64, HALF = 128, HTB = HALF * BK * 2  , STAGE_BYTES = 8 * HTB, NXCD = 8, WGM = 8;

__host__ __device__ __forceinline__ int lds_byte(int r, int c) { const int st = (r >> 4) * 2 + (c >> 5), rr = r & 15, cc = c & 31, ob = rr * 64 + cc * 2; return st * 1024 + (ob ^ (((ob >> 9) & 1) << 5)); }
__host__ __device__ __forceinline__ void stage_rc(int b, int& R, int& C) { const int st = b / 1024, sb = b % 1024, swz = sb ^ (((sb >> 9) & 1) << 5); R = (st >> 1) * 16 + swz / 64; C = (st & 1) * 32 + (swz % 64) / 2; }
__host__ __device__ __forceinline__ int perm32(int rho) { const int n = rho >> 4, i = rho & 15; return 8 * (i >> 2) + 4 * n + (i & 3); }

struct Unit { int pm, pn; };
struct Gemm { const bf16_t* A; const bf16_t* Bt; int M, N, K; };

struct StaticOrder {
    int nM, nN, nwg, G, c;
    __host__ __device__ void init(int M, int N, int G_, int c_) { nM = M / BM; nN = N / BM; nwg = nM * nN; G = G_; c = c_; }
    __host__ __device__ bool next(int i, Unit& u) const {
        const long L = (long)i * G + c; if (L >= nwg) return false;
        int wgid = (int)L; { const int q = nwg / NXCD, r = nwg % NXCD, xcd = wgid % NXCD, off = wgid / NXCD; wgid = (xcd < r ? xcd * (q + 1) : r * (q + 1) + (xcd - r) * q) + off; }
        const int nig = WGM * nN, gid = wgid / nig, fm = gid * WGM, gsz = (nM - fm) < WGM ? (nM - fm) : WGM;
        u.pm = fm + ((wgid % nig) % gsz); u.pn = (wgid % nig) / gsz; return true;
    }
    __device__ __forceinline__ void a_ready(const Unit&) const {}
    __device__ __forceinline__ void done(const Unit&) const {}
};

__device__ __forceinline__ unsigned cvt_pk_bf16(float lo, float hi) { unsigned r; asm volatile("v_cvt_pk_bf16_f32 %0, %1, %2" : "=v"(r) : "v"(lo), "v"(hi)); return r; }
typedef float f32x2 __attribute__((ext_vector_type(2)));
struct EpiF32 {
    static constexpr bool PERM = false, AFTER_DRAIN = false;
    float* C; int ldc;
    __device__ __forceinline__ void operator()(const f32x4 (&acc)[2][2][4][2], const Unit& u, int wr, int wc, int fr, int fq) const {
        const int row0 = u.pm * BM + wr * 64 + fr, col0 = u.pn * BM + wc * 32 + 4 * fq;
#pragma unroll
        for (int ai = 0; ai < 2; ++ai)
#pragma unroll
            for (int m = 0; m < 4; ++m) { float* rowp = C + (size_t)(row0 + ai * HALF + m * 16) * ldc + col0;
#pragma unroll
                for (int bj = 0; bj < 2; ++bj)
#pragma unroll
                    for (int n = 0; n < 2; ++n) *(f32x4*)(rowp + bj * HALF + n * 16) = acc[ai][bj][m][n]; }
    }
};
struct EpiBf16 {
    static constexpr bool PERM = true, AFTER_DRAIN = false;
    bf16_t* O; int ldc;
    __device__ __forceinline__ void operator()(const f32x4 (&acc)[2][2][4][2], const Unit& u, int wr, int wc, int fr, int fq) const {
        const int row0 = u.pm * BM + wr * 64 + fr; const int col0 = u.pn * BM + wc * 32 + 8 * fq;
#pragma unroll
        for (int ai = 0; ai < 2; ++ai)
#pragma unroll
            for (int m = 0; m < 4; ++m) { bf16_t* rowp = O + (size_t)(row0 + ai * HALF + m * 16) * ldc + col0;
#pragma unroll
                for (int bj = 0; bj < 2; ++bj) { const f32x4 v0 = acc[ai][bj][m][0], v1 = acc[ai][bj][m][1];
                    u32x4 w; w.x = cvt_pk_bf16(v0[0], v0[1]); w.y = cvt_pk_bf16(v0[2], v0[3]); w.z = cvt_pk_bf16(v1[0], v1[1]); w.w = cvt_pk_bf16(v1[2], v1[3]);
                    *(u32x4*)(rowp + bj * HALF) = w; } }
    }
};
__device__ __forceinline__ float silu_f(float g) { return g * __builtin_amdgcn_rcpf(1.0f + __builtin_amdgcn_exp2f(-1.4426950408889634f * g)); }
struct EpiSwiGLU {
    static constexpr bool PERM = true, AFTER_DRAIN = false;
    bf16_t* O; int ldc;
    __device__ __forceinline__ void operator()(const f32x4 (&acc)[2][2][4][2], const Unit& u, int wr, int wc, int fr, int fq) const {
        const int row0 = u.pm * BM + wr * 64 + fr; const int col0 = u.pn * HALF + wc * 32 + 8 * fq;
#pragma unroll
        for (int ai = 0; ai < 2; ++ai)
#pragma unroll
            for (int m = 0; m < 4; ++m) { bf16_t* rowp = O + (size_t)(row0 + ai * HALF + m * 16) * ldc + col0;
                const f32x4 g0 = acc[ai][0][m][0], g1 = acc[ai][0][m][1], u0 = acc[ai][1][m][0], u1 = acc[ai][1][m][1];
                u32x4 w; w.x = cvt_pk_bf16(silu_f(g0[0]) * u0[0], silu_f(g0[1]) * u0[1]); w.y = cvt_pk_bf16(silu_f(g0[2]) * u0[2], silu_f(g0[3]) * u0[3]);
                w.z = cvt_pk_bf16(silu_f(g1[0]) * u1[0], silu_f(g1[1]) * u1[1]); w.w = cvt_pk_bf16(silu_f(g1[2]) * u1[2], silu_f(g1[3]) * u1[3]);
                *(u32x4*)rowp = w; }
    }
};

template <class Epi, class Sched, bool ALIGN_EPI = false, bool SP2 = false>
__device__ __forceinline__ void gemm_phase(PG8_LAS unsigned char* lds, const Gemm g, const Sched& S, const Epi& E) {
    int tid_ = threadIdx.x; asm volatile("" : "+v"(tid_)); const int tid = tid_, wid = __builtin_amdgcn_readfirstlane(tid >> 6), lane = tid & 63, wr = wid >> 2, wc = wid & 3, fr = lane & 15, fq = lane >> 4;
    const int K = g.K, nt = K / BK;
    unsigned voffA[2], voffB[2];
#pragma unroll
    for (int i = 0; i < 2; ++i) { int R, C; stage_rc(tid * 16 + i * 8192, R, C); const int Rb = Epi::PERM ? ((R & ~31) + perm32(R & 31)) : R;
        voffA[i] = (unsigned)(R * K + C) * 2u; voffB[i] = (unsigned)(Rb * K + C) * 2u; }
    const size_t kstep = (size_t)(BK * 2);
    const size_t hstep = (size_t)HALF * K * 2;
    const size_t tstep = 2 * hstep;
    const unsigned ldsw = (unsigned)wid * 1024u;
    const int aoff = lds_byte(wr * 64 + fr, fq * 8), boff = lds_byte(wc * 32 + fr, fq * 8);
#define PG8_SA(b, h) (((b) * 2 + (h)) * HTB)
#define PG8_SB(b, h) ((4 + (b) * 2 + (h)) * HTB)
#define PG8_STAGE(bufoff, gbase, voff) do { _Pragma("unroll") for (int _i = 0; _i < 2; ++_i) \
        __builtin_amdgcn_global_load_lds((const unsigned*)((const char*)(gbase) + (voff)[_i]), (PG8_LAS unsigned*)(lds + (bufoff) + ldsw + _i * 8192), 16, 0, 0); } while (0)
#define PG8_LDA(dst, b, h) do { _Pragma("unroll") for (int m = 0; m < 4; ++m) _Pragma("unroll") for (int k = 0; k < 2; ++k) dst[m][k] = *(const PG8_LAS bf16x8*)(lds + PG8_SA(b, h) + aoff + m * 2048 + k * 1024); } while (0)
#define PG8_LDB(dst, b, h) do { _Pragma("unroll") for (int n = 0; n < 2; ++n) _Pragma("unroll") for (int k = 0; k < 2; ++k) dst[n][k] = *(const PG8_LAS bf16x8*)(lds + PG8_SB(b, h) + boff + n * 2048 + k * 1024); } while (0)
#define PG8_MMA(ai, bj, At, Bt) do { __builtin_amdgcn_s_setprio(1); _Pragma("unroll") for (int m = 0; m < 4; ++m) _Pragma("unroll") for (int n = 0; n < 2; ++n) _Pragma("unroll") for (int k = 0; k < 2; ++k) \
        acc[ai][bj][m][n] = __builtin_amdgcn_mfma_f32_16x16x32_bf16(Bt[n][k], At[m][k], acc[ai][bj][m][n], 0, 0, 0); __builtin_amdgcn_s_setprio(0); } while (0)
#define PG8_WAIT_V(n) asm volatile("s_waitcnt vmcnt(" #n ")" ::: "memory")
#define PG8_WAIT_L(n) asm volatile("s_waitcnt lgkmcnt(" #n ")" ::: "memory")
#define PG8_BAR __builtin_amdgcn_s_barrier()
#define PG8_SCHED __builtin_amdgcn_sched_barrier(0)
    Unit cur, nxt; int ui = 0;
    if (!S.next(0, cur)) return;
    f32x4 acc[2][2][4][2];
#pragma unroll
    for (int a = 0; a < 2; ++a)
#pragma unroll
        for (int b = 0; b < 2; ++b)
#pragma unroll
            for (int m = 0; m < 4; ++m)
#pragma unroll
                for (int n = 0; n < 2; ++n) acc[a][b][m][n] = (f32x4){0.f, 0.f, 0.f, 0.f};
    bf16x8 At[4][2], B0[2][2], B1[2][2];
    const char* cA = (const char*)g.A + (size_t)cur.pm * tstep; const char* cB = (const char*)g.Bt + (size_t)cur.pn * tstep;
    S.a_ready(cur);
    if constexpr (SP2) {
        PG8_STAGE(PG8_SB(0, 0), cB, voffB); PG8_STAGE(PG8_SB(0, 1), cB + hstep, voffB); PG8_STAGE(PG8_SA(0, 0), cA, voffA); PG8_STAGE(PG8_SA(0, 1), cA + hstep, voffA);
        if (wr == 1) PG8_BAR;
        PG8_WAIT_V(2); PG8_BAR;
        PG8_STAGE(PG8_SB(1, 0), cB + kstep, voffB); PG8_STAGE(PG8_SA(1, 0), cA + kstep, voffA); PG8_STAGE(PG8_SB(1, 1), cB + hstep + kstep, voffB);
        PG8_WAIT_V(6); PG8_BAR;
    } else {
        PG8_STAGE(PG8_SB(0, 0), cB, voffB); PG8_STAGE(PG8_SA(0, 0), cA, voffA); PG8_STAGE(PG8_SB(0, 1), cB + hstep, voffB); PG8_STAGE(PG8_SA(0, 1), cA + hstep, voffA);
        if (wr == 1) PG8_BAR;
        PG8_WAIT_V(4); PG8_BAR;
        PG8_STAGE(PG8_SB(1, 0), cB + kstep, voffB); PG8_STAGE(PG8_SA(1, 0), cA + kstep, voffA); PG8_STAGE(PG8_SB(1, 1), cB + hstep + kstep, voffB);
        PG8_WAIT_V(6); PG8_BAR;
    }
    for (;;) {
        const bool has_next = S.next(ui + 1, nxt);
        const char* nA = has_next ? (const char*)g.A + (size_t)nxt.pm * tstep : cA; const char* nB = has_next ? (const char*)g.Bt + (size_t)nxt.pn * tstep : cB;
        for (int t = 0; t < nt; t += 2) {
            const bool last = (t == nt - 2);
            const char* a1 = cA + (size_t)(t + 1) * kstep;
            const char* a2 = last ? nA : cA + (size_t)(t + 2) * kstep; const char* b2 = last ? nB : cB + (size_t)(t + 2) * kstep;
            const char* a3 = a2 + kstep; const char* b3 = b2 + kstep;
            if (last && has_next) S.a_ready(nxt);
            if constexpr (SP2) {
            PG8_LDB(B0, 0, 0); PG8_LDB(B1, 0, 1); PG8_SCHED; PG8_LDA(At, 0, 0); PG8_STAGE(PG8_SA(1, 1), a1 + hstep, voffA);
            PG8_WAIT_V(8); PG8_WAIT_L(0); PG8_BAR; PG8_MMA(0, 0, At, B0); PG8_MMA(0, 1, At, B1); PG8_BAR; PG8_SCHED;
            PG8_LDA(At, 0, 1); PG8_STAGE(PG8_SB(0, 0), b2, voffB); PG8_STAGE(PG8_SB(0, 1), b2 + hstep, voffB); PG8_STAGE(PG8_SA(0, 0), a2, voffA);
            PG8_WAIT_V(8); PG8_WAIT_L(0); PG8_BAR; PG8_MMA(1, 0, At, B0); PG8_MMA(1, 1, At, B1); PG8_BAR; PG8_SCHED;
            PG8_LDB(B0, 1, 0); PG8_LDB(B1, 1, 1); PG8_SCHED; PG8_LDA(At, 1, 0); PG8_STAGE(PG8_SA(0, 1), a2 + hstep, voffA);
            PG8_WAIT_V(8); PG8_WAIT_L(0); PG8_BAR; PG8_MMA(0, 0, At, B0); PG8_MMA(0, 1, At, B1); PG8_BAR; PG8_SCHED;
            PG8_LDA(At, 1, 1); PG8_STAGE(PG8_SB(1, 0), b3, voffB); PG8_STAGE(PG8_SB(1, 1), b3 + hstep, voffB); PG8_STAGE(PG8_SA(1, 0), a3, voffA);
            PG8_WAIT_V(8); PG8_WAIT_L(0); PG8_BAR; PG8_MMA(1, 0, At, B0); PG8_MMA(1, 1, At, B1); PG8_BAR; PG8_SCHED;
            } else {
            PG8_LDB(B0, 0, 0); PG8_SCHED; PG8_LDA(At, 0, 0); PG8_STAGE(PG8_SA(1, 1), a1 + hstep, voffA);
            PG8_WAIT_L(8); PG8_BAR; PG8_WAIT_L(0); PG8_MMA(0, 0, At, B0); PG8_BAR; PG8_SCHED;
            PG8_LDB(B1, 0, 1); PG8_STAGE(PG8_SB(0, 0), b2, voffB);
            PG8_BAR; PG8_WAIT_L(0); PG8_MMA(0, 1, At, B1); PG8_BAR;
            PG8_LDA(At, 0, 1); PG8_STAGE(PG8_SA(0, 0), a2, voffA);
            PG8_BAR; PG8_WAIT_L(0); PG8_MMA(1, 0, At, B0); PG8_BAR; PG8_SCHED;
            PG8_STAGE(PG8_SB(0, 1), b2 + hstep, voffB);
            PG8_WAIT_V(6); PG8_BAR; PG8_MMA(1, 1, At, B1); PG8_BAR;
            PG8_LDB(B0, 1, 0); PG8_SCHED; PG8_LDA(At, 1, 0); PG8_STAGE(PG8_SA(0, 1), a2 + hstep, voffA);
            PG8_WAIT_L(8); PG8_BAR; PG8_WAIT_L(0); PG8_MMA(0, 0, At, B0); PG8_BAR; PG8_SCHED;
            PG8_LDB(B1, 1, 1); PG8_STAGE(PG8_SB(1, 0), b3, voffB);
            PG8_BAR; PG8_WAIT_L(0); PG8_MMA(0, 1, At, B1); PG8_BAR;
            PG8_LDA(At, 1, 1); PG8_STAGE(PG8_SA(1, 0), a3, voffA);
            PG8_BAR; PG8_WAIT_L(0); PG8_MMA(1, 0, At, B0); PG8_BAR; PG8_SCHED;
            PG8_STAGE(PG8_SB(1, 1), b3 + hstep, voffB);
            PG8_WAIT_V(6); PG8_BAR; PG8_MMA(1, 1, At, B1); PG8_BAR;
            }
        }
        if constexpr (ALIGN_EPI) { if (wr == 0) PG8_BAR; }
        if constexpr (!Epi::AFTER_DRAIN) { E(acc, cur, wr, wc, fr, fq); S.done(cur); }
        if (!has_next) break;
#pragma unroll
        for (int a = 0; a < 2; ++a)
#pragma unroll
            for (int b = 0; b < 2; ++b)
#pragma unroll
                for (int m = 0; m < 4; ++m)
#pragma unroll
                    for (int n = 0; n < 2; ++n) acc[a][b][m][n] = (f32x4){0.f, 0.f, 0.f, 0.f};
        cur = nxt; cA = nA; cB = nB; ++ui;
        if constexpr (ALIGN_EPI) { if (wr == 1) PG8_BAR; }
    }
    PG8_WAIT_V(0);
    if constexpr (!ALIGN_EPI) { if (wr == 0) PG8_BAR; }
    PG8_BAR;
    if constexpr (Epi::AFTER_DRAIN) { E.fused(acc, cur, wr, wc, fr, fq, lds, wid, lane); S.done(cur); }
#undef PG8_SA
#undef PG8_SB
#undef PG8_STAGE
#undef PG8_LDA
#undef PG8_LDB
#undef PG8_MMA
#undef PG8_WAIT_V
#undef PG8_WAIT_L
#undef PG8_BAR
#undef PG8_SCHED
}
}

constexpr int NWAVES = 8;
constexpr int BATCH = 4, SEQ = 2048, D = 2048, M = BATCH * SEQ, DEPTH = 4;
constexpr int DFF = 5504, NFF1 = 2 * DFF;
constexpr int ML_H = 4, ML_DQK = 256, ML_DV = 512, ML_QK = 1024, ML_V = 2048, ML_IN = 6152, ML_N = 6144;
constexpr int GD_HK = 16, GD_HV = 32, GD_CONVCH = 8192, GD_IN = 12352, GD_N = 12288, GD_VTOT = 4096;
constexpr float EPS = 1e-6f;

constexpr size_t MiB = 1u << 20;
constexpr size_t WS_CTL = 0, CTL_ZERO_BYTES = 1 * MiB;
constexpr size_t SZ_W1 = (size_t)NFF1 * D * 2, SZ_W2 = (size_t)D * DFF * 2;
constexpr size_t SZ_MLIN = (size_t)ML_N * D * 2, SZ_MLOUT = (size_t)D * ML_V * 2, SZ_GDIN = (size_t)GD_N * D * 2, SZ_GDOUT = (size_t)D * GD_VTOT * 2;
constexpr size_t SZ_MLX = (size_t)16 * D * 2, SZ_GDX = (size_t)64 * D * 2;
constexpr size_t WS_W1 = 2 * MiB;
constexpr size_t WS_W2 = WS_W1 + 8 * SZ_W1;
constexpr size_t WS_MLIN = WS_W2 + 8 * SZ_W2;
constexpr size_t WS_MLOUT = WS_MLIN + 2 * SZ_MLIN;
constexpr size_t WS_GDIN = WS_MLOUT + 2 * SZ_MLOUT;
constexpr size_t WS_GDOUT = WS_GDIN + 2 * SZ_GDIN;
constexpr size_t WS_MLX = WS_GDOUT + 2 * SZ_GDOUT;
constexpr size_t WS_GDX = WS_MLX + 2 * SZ_MLX;
constexpr size_t WS_HN = WS_GDX + 2 * SZ_GDX;
constexpr size_t WS_ACT = WS_HN + (size_t)M * D * 2;
constexpr size_t WS_Y = WS_ACT + (size_t)M * DFF * 2;
constexpr size_t WS_PROJ = WS_Y + (size_t)M * D * 4;
constexpr size_t WS_GATES = WS_PROJ + (size_t)M * GD_N * 2;
constexpr size_t WS_SCAN = WS_GATES + (size_t)M * 64 * 4;
constexpr size_t WS_YMIX = WS_SCAN + (size_t)M * 4096 * 4;
constexpr size_t WS_END = WS_YMIX + (size_t)M * 4096 * 2;
static_assert(WS_W1 % 256 == 0 && WS_W2 % 256 == 0 && WS_HN % 256 == 0 && WS_ACT % 256 == 0 && WS_Y % 256 == 0 && WS_PROJ % 256 == 0 && WS_SCAN % 256 == 0 && WS_YMIX % 256 == 0, "alignment");
constexpr int CW_TMO = 0, CW_CODE = 1;
constexpr int CW_BAR = 4096;

constexpr int RING_OFF = 0, RING_BYTES = 131072;
constexpr int LDSCTL_OFF = RING_BYTES, MISC_OFF = LDSCTL_OFF + 320;
constexpr int LDS_BYTES = 147456;
static_assert(MISC_OFF + 128 <= LDS_BYTES, "LDS map");

#define GAS __attribute__((address_space(1)))
#define LAS __attribute__((address_space(3)))
typedef unsigned short bf16;
typedef unsigned v4u __attribute__((ext_vector_type(4)));
typedef unsigned v2u __attribute__((ext_vector_type(2)));
typedef float f32x4 __attribute__((ext_vector_type(4)));
typedef float f32x2 __attribute__((ext_vector_type(2)));
typedef short bf16x8 __attribute__((ext_vector_type(8)));
typedef GAS unsigned gu32;
#define RLX_AGENT __ATOMIC_RELAXED, __HIP_MEMORY_SCOPE_AGENT
#define LDS_WAIT() asm volatile("s_waitcnt lgkmcnt(0)" ::: "memory")
#define VM_WAIT() asm volatile("s_waitcnt vmcnt(0)" ::: "memory")
__device__ __forceinline__ unsigned f2bf(float f) { unsigned u = __builtin_bit_cast(unsigned, f); return (u + 0x7fffu + ((u >> 16) & 1u)) >> 16; }
__device__ __forceinline__ unsigned pk2(float lo, float hi) { return f2bf(lo) | (f2bf(hi) << 16); }
__device__ __forceinline__ float bf2f(unsigned short b) { return __builtin_bit_cast(float, (unsigned)b << 16); }
__device__ __forceinline__ float bflo(unsigned w) { return __builtin_bit_cast(float, w << 16); }
__device__ __forceinline__ float bfhi(unsigned w) { return __builtin_bit_cast(float, w & 0xffff0000u); }

#define XB_TMO      128
#define XB_XCNT(j)  (256  + 64 * (j))
#define XB_XSUB(j)  (1280 + 64 * (j))
#define XB_XGEN(j)  (2304 + 64 * (j))
#define XB_TOP      3328
#define XB_TOPGEN   3392
#define XCD_BAR_WORDS 3456
#define XB_SPIN_CAP (1u << 18)

__device__ __forceinline__ unsigned xb_ld(unsigned* p)              { return __hip_atomic_load(p, __ATOMIC_RELAXED, __HIP_MEMORY_SCOPE_AGENT); }
__device__ __forceinline__ unsigned xb_add(unsigned* p, unsigned v) { return __hip_atomic_fetch_add(p, v, __ATOMIC_RELAXED, __HIP_MEMORY_SCOPE_AGENT); }
__device__ __forceinline__ unsigned xb_xcc_id() { return (unsigned)__builtin_amdgcn_s_getreg((3 << 11) | 20) & 0xFu; }
#define XB_SPIN(cond, bar) do { unsigned _sp = 0; while (cond) { __builtin_amdgcn_s_sleep(1); \
    if ((++_sp & 255u) == 0u) { if (xb_ld(&(bar)[XB_TMO])) break; if (_sp > XB_SPIN_CAP) { atomicAdd(&(bar)[XB_TMO], 1u); break; } } } } while (0)

struct XcdBarrier {
    unsigned* bar; unsigned x;
    volatile LAS unsigned* st;
};
__device__ __forceinline__ XcdBarrier xcd_barrier_post(unsigned* bar, volatile LAS unsigned* st) {
    XcdBarrier b; b.bar = bar; b.x = xb_xcc_id(); b.st = st;
    if (threadIdx.x == 0) (void)xb_add(&bar[XB_XCNT(b.x)], 1u);
    return b;
}
__device__ __forceinline__ void xcd_barrier_complete(unsigned* bar, unsigned x, unsigned& nloc, unsigned& nx) {
    const unsigned G = gridDim.x * gridDim.y * gridDim.z;
    unsigned sum, cnt, mine, sp = 0u;
    for (;;) {
        sum = 0u; cnt = 0u; mine = 0u;
#pragma unroll
        for (unsigned j = 0; j < 16; ++j) { const unsigned c = xb_ld(&bar[XB_XCNT(j)]); sum += c; cnt += (c > 0u) ? 1u : 0u; mine = (j == x) ? c : mine; }
        if (sum == G) break;
        __builtin_amdgcn_s_sleep(1);
        if ((++sp & 255u) == 0u) { if (xb_ld(&bar[XB_TMO])) break; if (sp > XB_SPIN_CAP) { atomicAdd(&bar[XB_TMO], 1u); break; } }
    }
    nloc = mine > 0u ? mine : 1u; nx = cnt > 0u ? cnt : 1u;
}
__device__ __forceinline__ void xcd_barrier(const XcdBarrier& b) {
    asm volatile("s_waitcnt vmcnt(0)" ::: "memory");
    __syncthreads();
    if (threadIdx.x == 0) {
        unsigned* bar = b.bar;
        __builtin_amdgcn_s_waitcnt(0);
        unsigned nloc = b.st[0], nx = b.st[1];
        if (nloc == 0u) { xcd_barrier_complete(bar, b.x, nloc, nx); b.st[0] = nloc; b.st[1] = nx; }
        const unsigned old = xb_add(&bar[XB_XSUB(b.x)], 1u);
        const unsigned gen = old / nloc;
        if (old + 1u == (gen + 1u) * nloc) {
            __builtin_amdgcn_fence(__ATOMIC_RELEASE, "agent");
            asm volatile("s_waitcnt vmcnt(0)" ::: "memory");
            const unsigned og = xb_add(&bar[XB_TOP], 1u);
            const unsigned tg = og / nx;
            if (og + 1u == (tg + 1u) * nx) xb_add(&bar[XB_TOPGEN], 1u);
            else XB_SPIN(xb_ld(&bar[XB_TOPGEN]) == tg, bar);
            __builtin_amdgcn_fence(__ATOMIC_ACQUIRE, "agent");
            xb_add(&bar[XB_XGEN(b.x)], 1u);
            asm volatile("s_waitcnt vmcnt(0)" ::: "memory");
        } else {
            XB_SPIN(xb_ld(&bar[XB_XGEN(b.x)]) == gen, bar);
            __builtin_amdgcn_fence(__ATOMIC_ACQUIRE, "agent");
            asm volatile("s_waitcnt vmcnt(0)" ::: "memory");
        }
    }
    __syncthreads();
}

struct Frame {
    LAS unsigned char* lds;
    volatile LAS unsigned* MISC;
    gu32* ctl;
    int tid, lane, wave;
    int G;
    unsigned char* ws;
    float* out;
};
enum { I_X = 0, I_NORMG, I_FFN_IN, I_FFN_OUT, I_ML_IN, I_ML_IB, I_ML_FB, I_ML_HG, I_ML_OUT, I_GD_IN, I_GD_CONV, I_GD_ALOG, I_GD_DTB, I_GD_NG, I_GD_OUT };
constexpr int PTR_OFF = MISC_OFF + 128;
static_assert(PTR_OFF + 15 * 8 <= LDS_BYTES, "LDS map");
__device__ __forceinline__ const float* inp(const Frame& F, int i) {
    volatile LAS unsigned* p = (volatile LAS unsigned*)(F.lds + PTR_OFF) + 2 * i;
    const unsigned lo = __builtin_amdgcn_readfirstlane(p[0]), hi = __builtin_amdgcn_readfirstlane(p[1]);
    return (const float*)(((unsigned long long)hi << 32) | lo);
}
__device__ __forceinline__ void relaunder(Frame& F) { int t = threadIdx.x; asm volatile("" : "+v"(t)); F.tid = t; F.lane = t & 63; F.wave = __builtin_amdgcn_readfirstlane(t >> 6); }

__device__ __forceinline__ float wave_sum(float v) {
#pragma unroll
    for (int o = 1; o < 64; o <<= 1) v += __shfl_xor(v, o);
    return v;
}

__device__ __forceinline__ void tr_item(const float* W, int ldw, bf16* WT, int K, LAS float* scr, int lane) {
#pragma unroll 8
    for (int i = 0; i < 32; ++i) { const int kk = 2 * i + (lane >> 5); scr[kk * 33 + (lane & 31)] = ((const GAS float*)W)[(size_t)kk * ldw + (lane & 31)]; }
    LDS_WAIT(); asm volatile("" ::: "memory");
    const int c = lane & 7;
#pragma unroll
    for (int j = 0; j < 4; ++j) { const int n = (lane >> 3) + 8 * j; const LAS float* s = scr + (8 * c) * 33 + n;
        v4u o; o.x = pk2(s[0 * 33], s[1 * 33]); o.y = pk2(s[2 * 33], s[3 * 33]); o.z = pk2(s[4 * 33], s[5 * 33]); o.w = pk2(s[6 * 33], s[7 * 33]);
        *(GAS v4u*)(WT + (size_t)n * K + 8 * c) = o; }
    LDS_WAIT(); asm volatile("" ::: "memory");
}

__device__ __forceinline__ void row_store_hn(const f32x4 (&h)[8], const float* gain, bf16* orow, int lane) {
    float ss = 0.f;
#pragma unroll
    for (int j = 0; j < 8; ++j) ss += (h[j].x * h[j].x + h[j].y * h[j].y) + (h[j].z * h[j].z + h[j].w * h[j].w);
    const float rstd = 1.0f / sqrtf(wave_sum(ss) * (1.0f / D) + EPS);
    GAS v2u* o8 = (GAS v2u*)orow + lane;
    const GAS f32x4* gp = (const GAS f32x4*)gain + lane;
#pragma unroll
    for (int j = 0; j < 8; ++j) { const f32x4 g = gp[64 * j]; v2u w; w.x = pk2(h[j].x * rstd * g.x, h[j].y * rstd * g.y); w.y = pk2(h[j].z * rstd * g.z, h[j].w * rstd * g.w); o8[64 * j] = w; }
}

__device__ __forceinline__ void prologue(Frame& F) {
    LAS float* scr = (LAS float*)(F.lds + RING_OFF + F.wave * 16384);
    const int gw = blockIdx.x * NWAVES + F.wave, NGW = F.G * NWAVES;
    constexpr int I_A = 32 * 344, I_B = 86 * 64, I_C = 32 * 192, I_D = 32 * 64, I_E = 32 * 384, I_F = 64 * 64;
    constexpr int NITEMS = 8 * I_A + 8 * I_B + 2 * I_C + 2 * I_D + 2 * I_E + 2 * I_F;
    for (int it = gw; it < NITEMS; it += NGW) {
        int r = it;
        if (r < 8 * I_A) { const int inst = r / I_A; r -= inst * I_A; const int kb = r / 344, nb = r % 344; const int n0 = 32 * nb;
            const int nn = n0 < DFF ? n0 : n0 - DFF; const int drow = 256 * (nn / 128) + (nn % 128) + (n0 < DFF ? 0 : 128);
            tr_item(inp(F, I_FFN_IN) + (size_t)inst * D * NFF1 + (size_t)(64 * kb) * NFF1 + n0, NFF1, (bf16*)(F.ws + WS_W1 + inst * SZ_W1) + (size_t)drow * D + 64 * kb, D, scr, F.lane); continue; }
        r -= 8 * I_A;
        if (r < 8 * I_B) { const int inst = r / I_B; r -= inst * I_B; const int kb = r / 64, nb = r % 64;
            tr_item(inp(F, I_FFN_OUT) + (size_t)inst * DFF * D + (size_t)(64 * kb) * D + 32 * nb, D, (bf16*)(F.ws + WS_W2 + inst * SZ_W2) + (size_t)(32 * nb) * DFF + 64 * kb, DFF, scr, F.lane); continue; }
        r -= 8 * I_B;
        if (r < 2 * I_C) { const int inst = r / I_C; r -= inst * I_C; const int kb = r / 192, nb = r % 192;
            tr_item(inp(F, I_ML_IN) + (size_t)inst * D * ML_IN + (size_t)(64 * kb) * ML_IN + 32 * nb, ML_IN, (bf16*)(F.ws + WS_MLIN + inst * SZ_MLIN) + (size_t)(32 * nb) * D + 64 * kb, D, scr, F.lane); continue; }
        r -= 2 * I_C;
        if (r < 2 * I_D) { const int inst = r / I_D; r -= inst * I_D; const int kb = r / 64, nb = r % 64;
            tr_item(inp(F, I_ML_OUT) + (size_t)inst * ML_V * D + (size_t)(64 * kb) * D + 32 * nb, D, (bf16*)(F.ws + WS_MLOUT + inst * SZ_MLOUT) + (size_t)(32 * nb) * ML_V + 64 * kb, ML_V, scr, F.lane); continue; }
        r -= 2 * I_D;
        if (r < 2 * I_E) { const int inst = r / I_E; r -= inst * I_E; const int kb = r / 384, nb = r % 384;
            tr_item(inp(F, I_GD_IN) + (size_t)inst * D * GD_IN + (size_t)(64 * kb) * GD_IN + 32 * nb, GD_IN, (bf16*)(F.ws + WS_GDIN + inst * SZ_GDIN) + (size_t)(32 * nb) * D + 64 * kb, D, scr, F.lane); continue; }
        r -= 2 * I_E;
        { const int inst = r / I_F; r -= inst * I_F; const int kb = r / 64, nb = r % 64;
            tr_item(inp(F, I_GD_OUT) + (size_t)inst * GD_VTOT * D + (size_t)(64 * kb) * D + 32 * nb, D, (bf16*)(F.ws + WS_GDOUT + inst * SZ_GDOUT) + (size_t)(32 * nb) * GD_VTOT + 64 * kb, GD_VTOT, scr, F.lane); }
    }
    { const int gt = blockIdx.x * (NWAVES * 64) + F.tid, NGT = F.G * NWAVES * 64;
      for (int i = gt; i < 2 * 16 * D; i += NGT) { const int inst = i / (16 * D), rr = (i / D) % 16, k = i % D;
          const float v = rr < 8 ? inp(F, I_ML_IN)[(size_t)inst * D * ML_IN + (size_t)k * ML_IN + ML_N + rr] : 0.f; ((bf16*)(F.ws + WS_MLX))[i] = (bf16)f2bf(v); }
      for (int i = gt; i < 2 * 64 * D; i += NGT) { const int inst = i / (64 * D), rr = (i / D) % 64, k = i % D;
          ((bf16*)(F.ws + WS_GDX))[i] = (bf16)f2bf(inp(F, I_GD_IN)[(size_t)inst * D * GD_IN + (size_t)k * GD_IN + GD_N + rr]); } }
    for (int m = gw; m < M; m += NGW) {
        const GAS f32x4* xr = (const GAS f32x4*)(inp(F, I_X) + (size_t)m * D) + F.lane; GAS f32x4* hr = (GAS f32x4*)(F.out + (size_t)m * D) + F.lane;
        f32x4 h[8];
#pragma unroll
        for (int j = 0; j < 8; ++j) { h[j] = xr[64 * j]; hr[64 * j] = h[j]; }
        row_store_hn(h, inp(F, I_NORMG), (bf16*)(F.ws + WS_HN) + (size_t)m * D, F.lane);
    }
}

__device__ __forceinline__ void norm_phase(Frame& F, float alpha, const float* gpost, const float* gpre, bool write_hn) {
    const int gw = blockIdx.x * NWAVES + F.wave, NGW = F.G * NWAVES;
    const float* Y = (const float*)(F.ws + WS_Y);
    for (int m = gw; m < M; m += NGW) {
        const GAS f32x4* yr = (const GAS f32x4*)(Y + (size_t)m * D) + F.lane; GAS f32x4* hr = (GAS f32x4*)(F.out + (size_t)m * D) + F.lane;
        const GAS f32x4* gp = (const GAS f32x4*)gpost + F.lane;
        f32x4 y[8], h[8]; float ss = 0.f;
#pragma unroll
        for (int j = 0; j < 8; ++j) { y[j] = yr[64 * j]; h[j] = hr[64 * j]; ss += (y[j].x * y[j].x + y[j].y * y[j].y) + (y[j].z * y[j].z + y[j].w * y[j].w); }
        const float rs = alpha / sqrtf(wave_sum(ss) * (1.0f / D) + EPS);
#pragma unroll
        for (int j = 0; j < 8; ++j) { const f32x4 g = gp[64 * j]; h[j] = h[j] + (y[j] * rs) * g; hr[64 * j] = h[j]; }
        if (write_hn) row_store_hn(h, gpre, (bf16*)(F.ws + WS_HN) + (size_t)m * D, F.lane);
    }
}

template <int NT> __device__ __forceinline__ void skinny_phase(Frame& F, const bf16* Wx, float* out) {
    const int gw = blockIdx.x * NWAVES + F.wave, NGW = F.G * NWAVES; const int lane = F.lane, fr = lane & 15, fq = lane >> 4;
    const bf16* A = (const bf16*)(F.ws + WS_HN);
    for (int u = gw; u < M / 16; u += NGW) {
        f32x4 acc[NT];
#pragma unroll
        for (int n = 0; n < NT; ++n) acc[n] = (f32x4){0.f, 0.f, 0.f, 0.f};
        const bf16* ap = A + (size_t)(16 * u + fr) * D + fq * 8; const bf16* bp = Wx + (size_t)fr * D + fq * 8;
#pragma unroll 4
        for (int ks = 0; ks < D / 32; ++ks) {
            const bf16x8 a = *(const GAS bf16x8*)(ap + ks * 32);
#pragma unroll
            for (int n = 0; n < NT; ++n) { const bf16x8 b = *(const GAS bf16x8*)(bp + (size_t)n * 16 * D + ks * 32); acc[n] = __builtin_amdgcn_mfma_f32_16x16x32_bf16(a, b, acc[n], 0, 0, 0); }
        }
#pragma unroll
        for (int n = 0; n < NT; ++n)
#pragma unroll
            for (int j = 0; j < 4; ++j) out[(size_t)(16 * u + fq * 4 + j) * (16 * NT) + n * 16 + fr] = acc[n][j];
    }
}

__device__ __forceinline__ float softcap15(float x) { return 15.0f * tanhf(x * (1.0f / 15.0f)); }
__device__ __forceinline__ float logsigmoid_f(float x) { return x >= 0.f ? -log1pf(expf(-x)) : x - log1pf(expf(x)); }
__device__ __forceinline__ float softplus_f(float x) { return x > 20.f ? x : log1pf(expf(x)); }
__device__ __forceinline__ float sigmoid_f(float x) { return 1.0f / (1.0f + expf(-x)); }

__device__ __forceinline__ void ml_scan_slow(Frame& F, int j) {
    LAS float* qT = (LAS float*)(F.lds);
    LAS float* kT = qT + 16 * 256;
    LAS float* vT = kT + 16 * 256;
    LAS float* fwS = vT + 16 * 32;
    LAS float* iwS = fwS + 16;
    LAS float* emS = iwS + 16;
    LAS float* red = emS + 16;
    LAS float* redd = red + 2 * 16 * 32;
    const bf16* P = (const bf16*)(F.ws + WS_PROJ); const float* GT = (const float*)(F.ws + WS_GATES); float* O = (float*)(F.ws + WS_SCAN);
    const int tid = F.tid, e = tid & 31, dg = tid >> 5, d0 = 16 * dg;
    for (int item = blockIdx.x; item < BATCH * ML_H * 16; item += F.G) {
        const int b = item / (ML_H * 16), hh = (item / 16) % ML_H, sl = item % 16;
        const float ib = inp(F, I_ML_IB)[j * ML_H + hh], fb = inp(F, I_ML_FB)[j * ML_H + hh];
        float C[16], n[16]; float mcar = 0.f;
#pragma unroll
        for (int i = 0; i < 16; ++i) { C[i] = 0.f; n[i] = 0.f; }
        for (int t0 = 0; t0 < SEQ; t0 += 16) {
            __syncthreads();
            const size_t row0 = (size_t)b * SEQ + t0;
            for (int o = tid; o < 16 * 256; o += 512) { const int r = o >> 8, c = o & 255;
                qT[o] = bf2f(P[(row0 + r) * ML_N + hh * ML_DQK + c]) * 0.0625f; kT[o] = bf2f(P[(row0 + r) * ML_N + ML_QK + hh * ML_DQK + c]); }
            { const int r = tid >> 5, c = tid & 31; vT[tid] = bf2f(P[(row0 + r) * ML_N + 2 * ML_QK + hh * ML_DV + sl * 32 + c]); }
            if (tid == 0) {
                float m = mcar;
                for (int s = 0; s < 16; ++s) { const float il = softcap15(GT[(row0 + s) * 16 + hh] + ib); const float fl = logsigmoid_f(softcap15(GT[(row0 + s) * 16 + 4 + hh] + fb));
                    const float mn = fmaxf(fl + m, il); fwS[s] = expf(fl + m - mn); iwS[s] = expf(il - mn); emS[s] = expf(-mn); m = mn; }
                mcar = m;
            }
            __syncthreads();
            for (int s = 0; s < 16; ++s) {
                const float f = fwS[s], iw = iwS[s], v = vT[s * 32 + e]; float pn = 0.f, pd = 0.f;
#pragma unroll
                for (int i = 0; i < 16; ++i) { const float kk = kT[s * 256 + d0 + i] * iw, qq = qT[s * 256 + d0 + i]; C[i] = f * C[i] + kk * v; n[i] = f * n[i] + kk; pn += qq * C[i]; pd += qq * n[i]; }
                red[((s & 1) * 16 + dg) * 32 + e] = pn; if (e == 0) redd[(s & 1) * 16 + dg] = pd;
                __syncthreads();
                if (tid < 32) { float num = 0.f, den = 0.f;
#pragma unroll
                    for (int g = 0; g < 16; ++g) { num += red[((s & 1) * 16 + g) * 32 + tid]; den += redd[(s & 1) * 16 + g]; }
                    O[(row0 + s) * ML_V + hh * ML_DV + sl * 32 + tid] = num / fmaxf(fabsf(den), emS[s]); }
            }
        }
    }
}

__device__ __forceinline__ void ml_gate_phase(Frame& F, int j) {
    const int gw = blockIdx.x * NWAVES + F.wave, NGW = F.G * NWAVES;
    const float* S = (const float*)(F.ws + WS_SCAN); const bf16* P = (const bf16*)(F.ws + WS_PROJ); bf16* Yo = (bf16*)(F.ws + WS_YMIX);
    for (int m = gw; m < M; m += NGW) {
#pragma unroll
        for (int hh = 0; hh < ML_H; ++hh) {
            const GAS f32x4* sr = (const GAS f32x4*)(S + (size_t)m * ML_V + hh * ML_DV) + F.lane;
            const f32x4 a = sr[0], c = sr[64];
            const float ss = wave_sum((a.x * a.x + a.y * a.y) + (a.z * a.z + a.w * a.w) + (c.x * c.x + c.y * c.y) + (c.z * c.z + c.w * c.w));
            const float rstd = 1.0f / sqrtf(ss * (1.0f / ML_DV) + EPS);
            const GAS f32x4* gp = (const GAS f32x4*)(inp(F, I_ML_HG) + (size_t)(j * ML_H + hh) * ML_DV) + F.lane;
            const GAS v2u* op = (const GAS v2u*)(P + (size_t)m * ML_N + 2 * ML_QK + ML_V + hh * ML_DV) + F.lane;
            GAS v2u* yp = (GAS v2u*)(Yo + (size_t)m * ML_V + hh * ML_DV) + F.lane;
            { const f32x4 g = gp[0]; const v2u o = op[0]; v2u w;
              w.x = pk2(sigmoid_f(bflo(o.x)) * a.x * rstd * g.x, sigmoid_f(bfhi(o.x)) * a.y * rstd * g.y); w.y = pk2(sigmoid_f(bflo(o.y)) * a.z * rstd * g.z, sigmoid_f(bfhi(o.y)) * a.w * rstd * g.w); yp[0] = w; }
            { const f32x4 g = gp[64]; const v2u o = op[64]; v2u w;
              w.x = pk2(sigmoid_f(bflo(o.x)) * c.x * rstd * g.x, sigmoid_f(bfhi(o.x)) * c.y * rstd * g.y); w.y = pk2(sigmoid_f(bflo(o.y)) * c.z * rstd * g.z, sigmoid_f(bfhi(o.y)) * c.w * rstd * g.w); yp[64] = w; }
        }
    }
}

__device__ __forceinline__ void gdn_scan_slow(Frame& F, int j) {
    LAS float* qT = (LAS float*)(F.lds);
    LAS float* kT = qT + 16 * 128;
    LAS float* vT = kT + 16 * 128;
    LAS float* btS = vT + 16 * 64;
    LAS float* agS = btS + 16;
    LAS float* qsS = agS + 16;
    LAS float* ksS = qsS + 16;
    LAS float* red1 = ksS + 16;
    LAS float* red2 = red1 + 2 * 8 * 64;
    const bf16* P = (const bf16*)(F.ws + WS_PROJ); const float* GT = (const float*)(F.ws + WS_GATES); float* O = (float*)(F.ws + WS_SCAN);
    const float* CW = inp(F, I_GD_CONV) + (size_t)j * 4 * GD_CONVCH;
    const int tid = F.tid, e = tid & 63, dg = tid >> 6, d0 = 16 * dg;
    for (int item = blockIdx.x; item < BATCH * GD_HV * 2; item += F.G) {
        const int b = item / (GD_HV * 2), hv = (item >> 1) % GD_HV, half = item & 1, hk = hv >> 1;
        const float Aexp = expf(inp(F, I_GD_ALOG)[j * GD_HV + hv]), dtb = inp(F, I_GD_DTB)[j * GD_HV + hv];
        float S[16];
#pragma unroll
        for (int i = 0; i < 16; ++i) S[i] = 0.f;
        for (int t0 = 0; t0 < SEQ; t0 += 16) {
            __syncthreads();
            const size_t row0 = (size_t)b * SEQ + t0;
            for (int o = tid; o < 5120; o += 512) {
                int r, ch; LAS float* dst;
                if (o < 2048) { r = o >> 7; ch = hk * 128 + (o & 127); dst = qT + o; }
                else if (o < 4096) { r = (o - 2048) >> 7; ch = 2048 + hk * 128 + (o & 127); dst = kT + (o - 2048); }
                else { r = (o - 4096) >> 6; ch = 4096 + hv * 128 + half * 64 + (o & 63); dst = vT + (o - 4096); }
                float acc = 0.f;
#pragma unroll
                for (int tp = 0; tp < 4; ++tp) { const int t = t0 + r - 3 + tp; if (t >= 0) acc += CW[tp * GD_CONVCH + ch] * bf2f(P[((size_t)b * SEQ + t) * GD_N + ch]); }
                *dst = acc * sigmoid_f(acc);
            }
            if (tid < 16) { const float bp = GT[(row0 + tid) * 64 + hv], ap = GT[(row0 + tid) * 64 + 32 + hv];
                btS[tid] = sigmoid_f(bp); agS[tid] = expf(-Aexp * softplus_f(ap + dtb)); }
            __syncthreads();
#pragma unroll
            for (int i = 0; i < 4; ++i) { const int id = 4 * F.wave + i, isk = id >> 4, r = id & 15; const LAS float* arr = (isk ? kT : qT) + r * 128;
                const float x0 = arr[F.lane], x1 = arr[F.lane + 64]; const float ss = wave_sum(x0 * x0 + x1 * x1); const float sc = 1.0f / sqrtf(ss + EPS);
                if (F.lane == 0) { if (isk) ksS[r] = sc; else qsS[r] = sc * 0.08838834764831845f; } }
            __syncthreads();
            for (int s = 0; s < 16; ++s) {
                const float a = agS[s], bt = btS[s], ks = ksS[s], qs = qsS[s]; float p = 0.f;
#pragma unroll
                for (int i = 0; i < 16; ++i) { S[i] *= a; p += kT[s * 128 + d0 + i] * S[i]; }
                red1[((s & 1) * 8 + dg) * 64 + e] = p * ks;
                __syncthreads();
                float kS = 0.f;
#pragma unroll
                for (int g = 0; g < 8; ++g) kS += red1[((s & 1) * 8 + g) * 64 + e];
                const float vn = bt * (vT[s * 64 + e] - kS) * ks; float oo = 0.f;
#pragma unroll
                for (int i = 0; i < 16; ++i) { S[i] += kT[s * 128 + d0 + i] * vn; oo += qT[s * 128 + d0 + i] * S[i]; }
                red2[((s & 1) * 8 + dg) * 64 + e] = oo * qs;
                __syncthreads();
                if (tid < 64) { float r = 0.f;
#pragma unroll
                    for (int g = 0; g < 8; ++g) r += red2[((s & 1) * 8 + g) * 64 + tid];
                    O[(row0 + s) * GD_VTOT + hv * 128 + half * 64 + tid] = r; }
            }
        }
    }
}

__device__ __forceinline__ void gdn_gate_phase(Frame& F, int j) {
    const int gw = blockIdx.x * NWAVES + F.wave, NGW = F.G * NWAVES;
    const float* S = (const float*)(F.ws + WS_SCAN); const bf16* P = (const bf16*)(F.ws + WS_PROJ); bf16* Yo = (bf16*)(F.ws + WS_YMIX);
    const f32x2 g = *((const GAS f32x2*)(inp(F, I_GD_NG) + (size_t)j * 128) + F.lane);
    for (int m = gw; m < M; m += NGW) {
#pragma unroll 4
        for (int hv = 0; hv < GD_HV; ++hv) {
            const f32x2 a = *((const GAS f32x2*)(S + (size_t)m * GD_VTOT + hv * 128) + F.lane);
            const float ss = wave_sum(a.x * a.x + a.y * a.y); const float rstd = 1.0f / sqrtf(ss * (1.0f / 128.0f) + EPS);
            const unsigned z = *((const GAS unsigned*)(P + (size_t)m * GD_N + GD_CONVCH + hv * 128) + F.lane);
            const float z0 = bflo(z), z1 = bfhi(z);
            *((GAS unsigned*)(Yo + (size_t)m * GD_VTOT + hv * 128) + F.lane) = pk2(a.x * rstd * g.x * z0 * sigmoid_f(z0), a.y * rstd * g.y * z1 * sigmoid_f(z1));
        }
    }
}

struct Args { const float* in[15]; float* out; unsigned char* ws; };
__global__ void __launch_bounds__(NWAVES * 64, 2) mk_fwd(Args args) {
    extern __shared__ __attribute__((aligned(16))) unsigned char lds[];
    Frame F;
    F.lds = (LAS unsigned char*)lds;
    F.MISC = (volatile LAS unsigned*)(F.lds + MISC_OFF);
    F.tid = threadIdx.x; F.lane = F.tid & 63; F.wave = __builtin_amdgcn_readfirstlane(F.tid >> 6);
    F.G = gridDim.x;
    F.ws = args.ws; F.ctl = (gu32*)(args.ws + WS_CTL);
    F.out = args.out;
    for (int u = F.tid; u < (PTR_OFF - LDSCTL_OFF) / 4; u += NWAVES * 64) ((LAS unsigned*)(F.lds + LDSCTL_OFF))[u] = 0u;
    if (F.tid == 0) {
#pragma unroll
        for (int i = 0; i < 15; ++i) ((LAS unsigned long long*)(F.lds + PTR_OFF))[i] = (unsigned long long)args.in[i];
    }
    __syncthreads();
    XcdBarrier bar = xcd_barrier_post((unsigned*)(F.ctl + CW_BAR), F.MISC + 8);
#define GRID_BAR() xcd_barrier(bar)

    prologue(F); GRID_BAR();

    const pg8::bf16_t* HN = (const pg8::bf16_t*)(F.ws + WS_HN);
    for (int L = 0; L < DEPTH; ++L) {
        for (int s = 0; s < 2; ++s) {
            relaunder(F);
            { pg8::Gemm g{HN, (const pg8::bf16_t*)(F.ws + WS_W1 + (size_t)(2 * L + s) * SZ_W1), M, NFF1, D}; pg8::StaticOrder S; S.init(M, NFF1, F.G, (int)blockIdx.x);
              pg8::EpiSwiGLU E{(pg8::bf16_t*)(F.ws + WS_ACT), DFF};
              pg8::gemm_phase<pg8::EpiSwiGLU, pg8::StaticOrder, true, true>(F.lds + RING_OFF, g, S, E); }
            GRID_BAR();
            { pg8::Gemm g{(const pg8::bf16_t*)(F.ws + WS_ACT), (const pg8::bf16_t*)(F.ws + WS_W2 + (size_t)(2 * L + s) * SZ_W2), M, D, DFF}; pg8::StaticOrder S; S.init(M, D, F.G, (int)blockIdx.x);
              pg8::EpiF32 E{(float*)(F.ws + WS_Y), D};
              pg8::gemm_phase<pg8::EpiF32, pg8::StaticOrder, true, true>(F.lds + RING_OFF, g, S, E); }
            GRID_BAR();
            if (s == 0) norm_phase(F, 0.5f, inp(F, I_NORMG) + (size_t)L * 6 * D + 1 * D, inp(F, I_NORMG) + (size_t)L * 6 * D + 2 * D, true);
            else        norm_phase(F, 0.5f, inp(F, I_NORMG) + (size_t)L * 6 * D + 5 * D, inp(F, I_NORMG) + (size_t)L * 6 * D + 6 * D, L + 1 < DEPTH);
            GRID_BAR();
            if (s == 0) {
                const int j = L >> 1;
                relaunder(F);
                if ((L & 1) == 0) {
                    skinny_phase<1>(F, (const bf16*)(F.ws + WS_MLX + (size_t)j * SZ_MLX), (float*)(F.ws + WS_GATES));
                    { pg8::Gemm g{HN, (const pg8::bf16_t*)(F.ws + WS_MLIN + (size_t)j * SZ_MLIN), M, ML_N, D}; pg8::StaticOrder S; S.init(M, ML_N, F.G, (int)blockIdx.x);
                      pg8::EpiBf16 E{(pg8::bf16_t*)(F.ws + WS_PROJ), ML_N};
                      pg8::gemm_phase<pg8::EpiBf16, pg8::StaticOrder, true, true>(F.lds + RING_OFF, g, S, E); }
                    GRID_BAR();
                    ml_scan_slow(F, j);
                    GRID_BAR();
                    ml_gate_phase(F, j);
                    GRID_BAR();
                    { pg8::Gemm g{(const pg8::bf16_t*)(F.ws + WS_YMIX), (const pg8::bf16_t*)(F.ws + WS_MLOUT + (size_t)j * SZ_MLOUT), M, D, ML_V}; pg8::StaticOrder S; S.init(M, D, F.G, (int)blockIdx.x);
                      pg8::EpiF32 E{(float*)(F.ws + WS_Y), D};
                      pg8::gemm_phase<pg8::EpiF32, pg8::StaticOrder, true, true>(F.lds + RING_OFF, g, S, E); }
                    GRID_BAR();
                } else {
                    skinny_phase<4>(F, (const bf16*)(F.ws + WS_GDX + (size_t)j * SZ_GDX), (float*)(F.ws + WS_GATES));
                    { pg8::Gemm g{HN, (const pg8::bf16_t*)(F.ws + WS_GDIN + (size_t)j * SZ_GDIN), M, GD_N, D}; pg8::StaticOrder S; S.init(M, GD_N, F.G, (int)blockIdx.x);
                      pg8::EpiBf16 E{(pg8::bf16_t*)(F.ws + WS_PROJ), GD_N};
                      pg8::gemm_phase<pg8::EpiBf16, pg8::StaticOrder, true, true>(F.lds + RING_OFF, g, S, E); }
                    GRID_BAR();
                    gdn_scan_slow(F, j);
                    GRID_BAR();
                    gdn_gate_phase(F, j);
                    GRID_BAR();
                    { pg8::Gemm g{(const pg8::bf16_t*)(F.ws + WS_YMIX), (const pg8::bf16_t*)(F.ws + WS_GDOUT + (size_t)j * SZ_GDOUT), M, D, GD_VTOT}; pg8::StaticOrder S; S.init(M, D, F.G, (int)blockIdx.x);
                      pg8::EpiF32 E{(float*)(F.ws + WS_Y), D};
                      pg8::gemm_phase<pg8::EpiF32, pg8::StaticOrder, true, true>(F.lds + RING_OFF, g, S, E); }
                    GRID_BAR();
                }
                norm_phase(F, 1.0f, inp(F, I_NORMG) + (size_t)L * 6 * D + 3 * D, inp(F, I_NORMG) + (size_t)L * 6 * D + 4 * D, true);
                GRID_BAR();
            }
        }
    }
}

extern "C" void kernel_launch(void* const* d_in, const int* in_sizes, int n_in, void* d_out, int out_size, void* d_ws, size_t ws_size, hipStream_t stream) {
    static int grid = 0;
    if (grid == 0) {
        if (n_in != 15 || in_sizes[0] != M * D || out_size != M * D || ws_size < WS_END) { fprintf(stderr, "kernel_launch: unexpected shapes (n_in %d, in0 %d, out %d, ws %zu < %zu); nothing launched\n", n_in, n_in > 0 ? in_sizes[0] : -1, out_size, ws_size, (size_t)WS_END); grid = -1; return; }
        int dev = 0, cus = 0, per_cu = 0;
        if (hipGetDevice(&dev) != hipSuccess || hipDeviceGetAttribute(&cus, hipDeviceAttributeMultiprocessorCount, dev) != hipSuccess) { grid = -1; return; }
        if (hipFuncSetAttribute((const void*)mk_fwd, hipFuncAttributeMaxDynamicSharedMemorySize, LDS_BYTES) != hipSuccess) { fprintf(stderr, "kernel_launch: hipFuncSetAttribute failed\n"); grid = -1; return; }
        if (hipOccupancyMaxActiveBlocksPerMultiprocessor(&per_cu, (const void*)mk_fwd, NWAVES * 64, LDS_BYTES) != hipSuccess || per_cu < 1) { fprintf(stderr, "kernel_launch: occupancy query says %d\n", per_cu); (void)hipGetLastError(); grid = -1; return; }
        (void)hipGetLastError();
        grid = cus;
    }
    if (grid < 0) return;
    if (hipMemsetAsync((char*)d_ws + WS_CTL, 0, CTL_ZERO_BYTES, stream) != hipSuccess) return;
    Args a{};
    for (int i = 0; i < 15; ++i) a.in[i] = (const float*)d_in[i];
    a.out = (float*)d_out; a.ws = (unsigned char*)d_ws;
    hipLaunchKernelGGL(mk_fwd, dim3(grid), dim3(NWAVES * 64), LDS_BYTES, stream, a);
}
```

```cpp
#include <hip/hip_runtime.h>
#include <cstdio>
#include <cstdint>
namespace pg8 {
#define PG8_LAS __attribute__((address_space(3)))
typedef unsigned short bf16_t;
typedef short bf16x8 __attribute__((ext_vector_type(8)));
typedef float f32x4 __attribute__((ext_vector_type(4)));
typedef unsigned u32x4 __attribute__((ext_vector_type(4)));
constexpr int BM = 256, BK = 64, HALF = 128, HTB = HALF * BK * 2  , STAGE_BYTES = 8 * HTB, NXCD = 8, WGM = 8;

__host__ __device__ __forceinline__ int lds_byte(int r, int c) { const int st = (r >> 4) * 2 + (c >> 5), rr = r & 15, cc = c & 31, ob = rr * 64 + cc * 2; return st * 1024 + (ob ^ (((ob >> 9) & 1) << 5)); }
__host__ __device__ __forceinline__ void stage_rc(int b, int& R, int& C) { const int st = b / 1024, sb = b % 1024, swz = sb ^ (((sb >> 9) & 1) << 5); R = (st >> 1) * 16 + swz / 64; C = (st & 1) * 32 + (swz % 64) / 2; }
__host__ __device__ __forceinline__ int perm32(int rho) { const int n = rho >> 4, i = rho & 15; return 8 * (i >> 2) + 4 * n + (i & 3); }

struct Unit { int pm, pn; };
struct Gemm { const bf16_t* A; const bf16_t* Bt; int M, N, K; };

struct StaticOrder {
    int nM, nN, nwg, G, c;
    __host__ __device__ void init(int M, int N, int G_, int c_) { nM = M / BM; nN = N / BM; nwg = nM * nN; G = G_; c = c_; }
    __host__ __device__ bool next(int i, Unit& u) const {
        const long L = (long)i * G + c; if (L >= nwg) return false;
        int wgid = (int)L; { const int q = nwg / NXCD, r = nwg % NXCD, xcd = wgid % NXCD, off = wgid / NXCD; wgid = (xcd < r ? xcd * (q + 1) : r * (q + 1) + (xcd - r) * q) + off; }
        const int nig = WGM * nN, gid = wgid / nig, fm = gid * WGM, gsz = (nM - fm) < WGM ? (nM - fm) : WGM;
        u.pm = fm + ((wgid % nig) % gsz); u.pn = (wgid % nig) / gsz; return true;
    }
    __device__ __forceinline__ void a_ready(const Unit&) const {}
    __device__ __forceinline__ void done(const Unit&) const {}
};

__device__ __forceinline__ unsigned cvt_pk_bf16(float lo, float hi) { unsigned r; asm volatile("v_cvt_pk_bf16_f32 %0, %1, %2" : "=v"(r) : "v"(lo), "v"(hi)); return r; }
typedef float f32x2 __attribute__((ext_vector_type(2)));
struct EpiF32 {
    static constexpr bool PERM = false, AFTER_DRAIN = false;
    float* C; int ldc;
    __device__ __forceinline__ void operator()(const f32x4 (&acc)[2][2][4][2], const Unit& u, int wr, int wc, int fr, int fq) const {
        const int row0 = u.pm * BM + wr * 64 + fr, col0 = u.pn * BM + wc * 32 + 4 * fq;
#pragma unroll
        for (int ai = 0; ai < 2; ++ai)
#pragma unroll
            for (int m = 0; m < 4; ++m) { float* rowp = C + (size_t)(row0 + ai * HALF + m * 16) * ldc + col0;
#pragma unroll
                for (int bj = 0; bj < 2; ++bj)
#pragma unroll
                    for (int n = 0; n < 2; ++n) *(f32x4*)(rowp + bj * HALF + n * 16) = acc[ai][bj][m][n]; }
    }
};
struct EpiBf16 {
    static constexpr bool PERM = true, AFTER_DRAIN = false;
    bf16_t* O; int ldc;
    __device__ __forceinline__ void operator()(const f32x4 (&acc)[2][2][4][2], const Unit& u, int wr, int wc, int fr, int fq) const {
        const int row0 = u.pm * BM + wr * 64 + fr; const int col0 = u.pn * BM + wc * 32 + 8 * fq;
#pragma unroll
        for (int ai = 0; ai < 2; ++ai)
#pragma unroll
            for (int m = 0; m < 4; ++m) { bf16_t* rowp = O + (size_t)(row0 + ai * HALF + m * 16) * ldc + col0;
#pragma unroll
                for (int bj = 0; bj < 2; ++bj) { const f32x4 v0 = acc[ai][bj][m][0], v1 = acc[ai][bj][m][1];
                    u32x4 w; w.x = cvt_pk_bf16(v0[0], v0[1]); w.y = cvt_pk_bf16(v0[2], v0[3]); w.z = cvt_pk_bf16(v1[0], v1[1]); w.w = cvt_pk_bf16(v1[2], v1[3]);
                    *(u32x4*)(rowp + bj * HALF) = w; } }
    }
};
__device__ __forceinline__ float silu_f(float g) { return g * __builtin_amdgcn_rcpf(1.0f + __builtin_amdgcn_exp2f(-1.4426950408889634f * g)); }
struct EpiSwiGLU {
    static constexpr bool PERM = true, AFTER_DRAIN = false;
    bf16_t* O; int ldc;
    __device__ __forceinline__ void operator()(const f32x4 (&acc)[2][2][4][2], const Unit& u, int wr, int wc, int fr, int fq) const {
        const int row0 = u.pm * BM + wr * 64 + fr; const int col0 = u.pn * HALF + wc * 32 + 8 * fq;
#pragma unroll
        for (int ai = 0; ai < 2; ++ai)
#pragma unroll
            for (int m = 0; m < 4; ++m) { bf16_t* rowp = O + (size_t)(row0 + ai * HALF + m * 16) * ldc + col0;
                const f32x4 g0 = acc[ai][0][m][0], g1 = acc[ai][0][m][1], u0 = acc[ai][1][m][0], u1 = acc[ai][1][m][1];
                u32x4 w; w.x = cvt_pk_bf16(silu_f(g0[0]) * u0[0], silu_f(g0[1]) * u0[1]); w.y = cvt_pk_bf16(silu_f(g0[2]) * u0[2], silu_f(g0[3]) * u0[3]);
                w.z = cvt_pk_bf16(silu_f(g1[0]) * u1[0], silu_f(g1[1]) * u1[1]); w.w = cvt_pk_bf16(silu_f(g1[2]) * u1[2], silu_f(g1[3]) * u1[3]);
                *(u32x4*)rowp = w; }
    }
};

template <class Epi, class Sched, bool ALIGN_EPI = false, bool SP2 = false>
__device__ __forceinline__ void gemm_phase(PG8_LAS unsigned char* lds, const Gemm g, const Sched& S, const Epi& E) {
    int tid_ = threadIdx.x; asm volatile("" : "+v"(tid_)); const int tid = tid_, wid = __builtin_amdgcn_readfirstlane(tid >> 6), lane = tid & 63, wr = wid >> 2, wc = wid & 3, fr = lane & 15, fq = lane >> 4;
    const int K = g.K, nt = K / BK;
    unsigned voffA[2], voffB[2];
#pragma unroll
    for (int i = 0; i < 2; ++i) { int R, C; stage_rc(tid * 16 + i * 8192, R, C); const int Rb = Epi::PERM ? ((R & ~31) + perm32(R & 31)) : R;
        voffA[i] = (unsigned)(R * K + C) * 2u; voffB[i] = (unsigned)(Rb * K + C) * 2u; }
    const size_t kstep = (size_t)(BK * 2);
    const size_t hstep = (size_t)HALF * K * 2;
    const size_t tstep = 2 * hstep;
    const unsigned ldsw = (unsigned)wid * 1024u;
    const int aoff = lds_byte(wr * 64 + fr, fq * 8), boff = lds_byte(wc * 32 + fr, fq * 8);
#define PG8_SA(b, h) (((b) * 2 + (h)) * HTB)
#define PG8_SB(b, h) ((4 + (b) * 2 + (h)) * HTB)
#define PG8_STAGE(bufoff, gbase, voff) do { _Pragma("unroll") for (int _i = 0; _i < 2; ++_i) \
        __builtin_amdgcn_global_load_lds((const unsigned*)((const char*)(gbase) + (voff)[_i]), (PG8_LAS unsigned*)(lds + (bufoff) + ldsw + _i * 8192), 16, 0, 0); } while (0)
#define PG8_LDA(dst, b, h) do { _Pragma("unroll") for (int m = 0; m < 4; ++m) _Pragma("unroll") for (int k = 0; k < 2; ++k) dst[m][k] = *(const PG8_LAS bf16x8*)(lds + PG8_SA(b, h) + aoff + m * 2048 + k * 1024); } while (0)
#define PG8_LDB(dst, b, h) do { _Pragma("unroll") for (int n = 0; n < 2; ++n) _Pragma("unroll") for (int k = 0; k < 2; ++k) dst[n][k] = *(const PG8_LAS bf16x8*)(lds + PG8_SB(b, h) + boff + n * 2048 + k * 1024); } while (0)
#define PG8_MMA(ai, bj, At, Bt) do { __builtin_amdgcn_s_setprio(1); _Pragma("unroll") for (int m = 0; m < 4; ++m) _Pragma("unroll") for (int n = 0; n < 2; ++n) _Pragma("unroll") for (int k = 0; k < 2; ++k) \
        acc[ai][bj][m][n] = __builtin_amdgcn_mfma_f32_16x16x32_bf16(Bt[n][k], At[m][k], acc[ai][bj][m][n], 0, 0, 0); __builtin_amdgcn_s_setprio(0); } while (0)
#define PG8_WAIT_V(n) asm volatile("s_waitcnt vmcnt(" #n ")" ::: "memory")
#define PG8_WAIT_L(n) asm volatile("s_waitcnt lgkmcnt(" #n ")" ::: "memory")
#define PG8_BAR __builtin_amdgcn_s_barrier()
#define PG8_SCHED __builtin_amdgcn_sched_barrier(0)
    Unit cur, nxt; int ui = 0;
    if (!S.next(0, cur)) return;
    f32x4 acc[2][2][4][2];
#pragma unroll
    for (int a = 0; a < 2; ++a)
#pragma unroll
        for (int b = 0; b < 2; ++b)
#pragma unroll
            for (int m = 0; m < 4; ++m)
#pragma unroll
                for (int n = 0; n < 2; ++n) acc[a][b][m][n] = (f32x4){0.f, 0.f, 0.f, 0.f};
    bf16x8 At[4][2], B0[2][2], B1[2][2];
    const char* cA = (const char*)g.A + (size_t)cur.pm * tstep; const char* cB = (const char*)g.Bt + (size_t)cur.pn * tstep;
    S.a_ready(cur);
    if constexpr (SP2) {
        PG8_STAGE(PG8_SB(0, 0), cB, voffB); PG8_STAGE(PG8_SB(0, 1), cB + hstep, voffB); PG8_STAGE(PG8_SA(0, 0), cA, voffA); PG8_STAGE(PG8_SA(0, 1), cA + hstep, voffA);
        if (wr == 1) PG8_BAR;
        PG8_WAIT_V(2); PG8_BAR;
        PG8_STAGE(PG8_SB(1, 0), cB + kstep, voffB); PG8_STAGE(PG8_SA(1, 0), cA + kstep, voffA); PG8_STAGE(PG8_SB(1, 1), cB + hstep + kstep, voffB);
        PG8_WAIT_V(6); PG8_BAR;
    } else {
        PG8_STAGE(PG8_SB(0, 0), cB, voffB); PG8_STAGE(PG8_SA(0, 0), cA, voffA); PG8_STAGE(PG8_SB(0, 1), cB + hstep, voffB); PG8_STAGE(PG8_SA(0, 1), cA + hstep, voffA);
        if (wr == 1) PG8_BAR;
        PG8_WAIT_V(4); PG8_BAR;
        PG8_STAGE(PG8_SB(1, 0), cB + kstep, voffB); PG8_STAGE(PG8_SA(1, 0), cA + kstep, voffA); PG8_STAGE(PG8_SB(1, 1), cB + hstep + kstep, voffB);
        PG8_WAIT_V(6); PG8_BAR;
    }
    for (;;) {
        const bool has_next = S.next(ui + 1, nxt);
        const char* nA = has_next ? (const char*)g.A + (size_t)nxt.pm * tstep : cA; const char* nB = has_next ? (const char*)g.Bt + (size_t)nxt.pn * tstep : cB;
        for (int t = 0; t < nt; t += 2) {
            const bool last = (t == nt - 2);
            const char* a1 = cA + (size_t)(t + 1) * kstep;
            const char* a2 = last ? nA : cA + (size_t)(t + 2) * kstep; const char* b2 = last ? nB : cB + (size_t)(t + 2) * kstep;
            const char* a3 = a2 + kstep; const char* b3 = b2 + kstep;
            if (last && has_next) S.a_ready(nxt);
            if constexpr (SP2) {
            PG8_LDB(B0, 0, 0); PG8_LDB(B1, 0, 1); PG8_SCHED; PG8_LDA(At, 0, 0); PG8_STAGE(PG8_SA(1, 1), a1 + hstep, voffA);
            PG8_WAIT_V(8); PG8_WAIT_L(0); PG8_BAR; PG8_MMA(0, 0, At, B0); PG8_MMA(0, 1, At, B1); PG8_BAR; PG8_SCHED;
            PG8_LDA(At, 0, 1); PG8_STAGE(PG8_SB(0, 0), b2, voffB); PG8_STAGE(PG8_SB(0, 1), b2 + hstep, voffB); PG8_STAGE(PG8_SA(0, 0), a2, voffA);
            PG8_WAIT_V(8); PG8_WAIT_L(0); PG8_BAR; PG8_MMA(1, 0, At, B0); PG8_MMA(1, 1, At, B1); PG8_BAR; PG8_SCHED;
            PG8_LDB(B0, 1, 0); PG8_LDB(B1, 1, 1); PG8_SCHED; PG8_LDA(At, 1, 0); PG8_STAGE(PG8_SA(0, 1), a2 + hstep, voffA);
            PG8_WAIT_V(8); PG8_WAIT_L(0); PG8_BAR; PG8_MMA(0, 0, At, B0); PG8_MMA(0, 1, At, B1); PG8_BAR; PG8_SCHED;
            PG8_LDA(At, 1, 1); PG8_STAGE(PG8_SB(1, 0), b3, voffB); PG8_STAGE(PG8_SB(1, 1), b3 + hstep, voffB); PG8_STAGE(PG8_SA(1, 0), a3, voffA);
            PG8_WAIT_V(8); PG8_WAIT_L(0); PG8_BAR; PG8_MMA(1, 0, At, B0); PG8_MMA(1, 1, At, B1); PG8_BAR; PG8_SCHED;
            } else {
            PG8_LDB(B0, 0, 0); PG8_SCHED; PG8_LDA(At, 0, 0); PG8_STAGE(PG8_SA(1, 1), a1 + hstep, voffA);
            PG8_WAIT_L(8); PG8_BAR; PG8_WAIT_L(0); PG8_MMA(0, 0, At, B0); PG8_BAR; PG8_SCHED;
            PG8_LDB(B1, 0, 1); PG8_STAGE(PG8_SB(0, 0), b2, voffB);
            PG8_BAR; PG8_WAIT_L(0); PG8_MMA(0, 1, At, B1); PG8_BAR;
            PG8_LDA(At, 0, 1); PG8_STAGE(PG8_SA(0, 0), a2, voffA);
            PG8_BAR; PG8_WAIT_L(0); PG8_MMA(1, 0, At, B0); PG8_BAR; PG8_SCHED;
            PG8_STAGE(PG8_SB(0, 1), b2 + hstep, voffB);
            PG8_WAIT_V(6); PG8_BAR; PG8_MMA(1, 1, At, B1); PG8_BAR;
            PG8_LDB(B0, 1, 0); PG8_SCHED; PG8_LDA(At, 1, 0); PG8_STAGE(PG8_SA(0, 1), a2 + hstep, voffA);
            PG8_WAIT_L(8); PG8_BAR; PG8_WAIT_L(0); PG8_MMA(0, 0, At, B0); PG8_BAR; PG8_SCHED;
            PG8_LDB(B1, 1, 1); PG8_STAGE(PG8_SB(1, 0), b3, voffB);
            PG8_BAR; PG8_WAIT_L(0); PG8_MMA(0, 1, At, B1); PG8_BAR;
            PG8_LDA(At, 1, 1); PG8_STAGE(PG8_SA(1, 0), a3, voffA);
            PG8_BAR; PG8_WAIT_L(0); PG8_MMA(1, 0, At, B0); PG8_BAR; PG8_SCHED;
            PG8_STAGE(PG8_SB(1, 1), b3 + hstep, voffB);
            PG8_WAIT_V(6); PG8_BAR; PG8_MMA(1, 1, At, B1); PG8_BAR;
            }
        }
        if constexpr (ALIGN_EPI) { if (wr == 0) PG8_BAR; }
        if constexpr (!Epi::AFTER_DRAIN) { E(acc, cur, wr, wc, fr, fq); S.done(cur); }
        if (!has_next) break;
#pragma unroll
        for (int a = 0; a < 2; ++a)
#pragma unroll
            for (int b = 0; b < 2; ++b)
#pragma unroll
                for (int m = 0; m < 4; ++m)
#pragma unroll
                    for (int n = 0; n < 2; ++n) acc[a][b][m][n] = (f32x4){0.f, 0.f, 0.f, 0.f};
        cur = nxt; cA = nA; cB = nB; ++ui;
        if constexpr (ALIGN_EPI) { if (wr == 1) PG8_BAR; }
    }
    PG8_WAIT_V(0);
    if constexpr (!ALIGN_EPI) { if (wr == 0) PG8_BAR; }
    PG8_BAR;
    if constexpr (Epi::AFTER_DRAIN) { E.fused(acc, cur, wr, wc, fr, fq, lds, wid, lane); S.done(cur); }
#undef PG8_SA
#undef PG8_SB
#undef PG8_STAGE
#undef PG8_LDA
#undef PG8_LDB
#undef PG8_MMA
#undef PG8_WAIT_V
#undef PG8_WAIT_L
#undef PG8_BAR
#undef PG8_SCHED
}
}

constexpr int NWAVES = 8;
constexpr int BATCH = 4, SEQ = 2048, D = 2048, M = BATCH * SEQ, DEPTH = 4;
constexpr int DFF = 5504, NFF1 = 2 * DFF;
constexpr int ML_H = 4, ML_DQK = 256, ML_DV = 512, ML_QK = 1024, ML_V = 2048, ML_IN = 6152, ML_N = 6144;
constexpr int GD_HK = 16, GD_HV = 32, GD_CONVCH = 8192, GD_IN = 12352, GD_N = 12288, GD_VTOT = 4096;
constexpr float EPS = 1e-6f;

constexpr size_t MiB = 1u << 20;
constexpr size_t WS_CTL = 0, CTL_ZERO_BYTES = 1 * MiB;
constexpr size_t SZ_W1 = (size_t)NFF1 * D * 2, SZ_W2 = (size_t)D * DFF * 2;
constexpr size_t SZ_MLIN = (size_t)ML_N * D * 2, SZ_MLOUT = (size_t)D * ML_V * 2, SZ_GDIN = (size_t)GD_N * D * 2, SZ_GDOUT = (size_t)D * GD_VTOT * 2;
constexpr size_t SZ_MLX = (size_t)16 * D * 2, SZ_GDX = (size_t)64 * D * 2;
constexpr size_t WS_W1 = 2 * MiB;
constexpr size_t WS_W2 = WS_W1 + 8 * SZ_W1;
constexpr size_t WS_MLIN = WS_W2 + 8 * SZ_W2;
constexpr size_t WS_MLOUT = WS_MLIN + 2 * SZ_MLIN;
constexpr size_t WS_GDIN = WS_MLOUT + 2 * SZ_MLOUT;
constexpr size_t WS_GDOUT = WS_GDIN + 2 * SZ_GDIN;
constexpr size_t WS_MLX = WS_GDOUT + 2 * SZ_GDOUT;
constexpr size_t WS_GDX = WS_MLX + 2 * SZ_MLX;
constexpr size_t WS_HN = WS_GDX + 2 * SZ_GDX;
constexpr size_t WS_ACT = WS_HN + (size_t)M * D * 2;
constexpr size_t WS_Y = WS_ACT + (size_t)M * DFF * 2;
constexpr size_t WS_PROJ = WS_Y + (size_t)M * D * 4;
constexpr size_t WS_GATES = WS_PROJ + (size_t)M * GD_N * 2;
constexpr size_t WS_SCAN = WS_GATES + (size_t)M * 64 * 4;
constexpr size_t WS_YMIX = WS_SCAN + (size_t)M * 4096 * 4;
constexpr size_t WS_END = WS_YMIX + (size_t)M * 4096 * 2;
static_assert(WS_W1 % 256 == 0 && WS_W2 % 256 == 0 && WS_HN % 256 == 0 && WS_ACT % 256 == 0 && WS_Y % 256 == 0 && WS_PROJ % 256 == 0 && WS_SCAN % 256 == 0 && WS_YMIX % 256 == 0, "alignment");
constexpr int CW_TMO = 0, CW_CODE = 1;
constexpr int CW_BAR = 4096;

constexpr int RING_OFF = 0, RING_BYTES = 131072;
constexpr int LDSCTL_OFF = RING_BYTES, MISC_OFF = LDSCTL_OFF + 320;
constexpr int LDS_BYTES = 147456;
static_assert(MISC_OFF + 128 <= LDS_BYTES, "LDS map");

#define GAS __attribute__((address_space(1)))
#define LAS __attribute__((address_space(3)))
typedef unsigned short bf16;
typedef unsigned v4u __attribute__((ext_vector_type(4)));
typedef unsigned v2u __attribute__((ext_vector_type(2)));
typedef float f32x4 __attribute__((ext_vector_type(4)));
typedef float f32x2 __attribute__((ext_vector_type(2)));
typedef short bf16x8 __attribute__((ext_vector_type(8)));
typedef GAS unsigned gu32;
#define RLX_AGENT __ATOMIC_RELAXED, __HIP_MEMORY_SCOPE_AGENT
#define LDS_WAIT() asm volatile("s_waitcnt lgkmcnt(0)" ::: "memory")
#define VM_WAIT() asm volatile("s_waitcnt vmcnt(0)" ::: "memory")
__device__ __forceinline__ unsigned f2bf(float f) { unsigned u = __builtin_bit_cast(unsigned, f); return (u + 0x7fffu + ((u >> 16) & 1u)) >> 16; }
__device__ __forceinline__ unsigned pk2(float lo, float hi) { return f2bf(lo) | (f2bf(hi) << 16); }
__device__ __forceinline__ float bf2f(unsigned short b) { return __builtin_bit_cast(float, (unsigned)b << 16); }
__device__ __forceinline__ float bflo(unsigned w) { return __builtin_bit_cast(float, w << 16); }
__device__ __forceinline__ float bfhi(unsigned w) { return __builtin_bit_cast(float, w & 0xffff0000u); }

#define XB_TMO      128
#define XB_XCNT(j)  (256  + 64 * (j))
#define XB_XSUB(j)  (1280 + 64 * (j))
#define XB_XGEN(j)  (2304 + 64 * (j))
#define XB_TOP      3328
#define XB_TOPGEN   3392
#define XCD_BAR_WORDS 3456
#define XB_SPIN_CAP (1u << 18)

__device__ __forceinline__ unsigned xb_ld(unsigned* p)              { return __hip_atomic_load(p, __ATOMIC_RELAXED, __HIP_MEMORY_SCOPE_AGENT); }
__device__ __forceinline__ unsigned xb_add(unsigned* p, unsigned v) { return __hip_atomic_fetch_add(p, v, __ATOMIC_RELAXED, __HIP_MEMORY_SCOPE_AGENT); }
__device__ __forceinline__ unsigned xb_xcc_id() { return (unsigned)__builtin_amdgcn_s_getreg((3 << 11) | 20) & 0xFu; }
#define XB_SPIN(cond, bar) do { unsigned _sp = 0; while (cond) { __builtin_amdgcn_s_sleep(1); \
    if ((++_sp & 255u) == 0u) { if (xb_ld(&(bar)[XB_TMO])) break; if (_sp > XB_SPIN_CAP) { atomicAdd(&(bar)[XB_TMO], 1u); break; } } } } while (0)

struct XcdBarrier {
    unsigned* bar; unsigned x;
    volatile LAS unsigned* st;
};
__device__ __forceinline__ XcdBarrier xcd_barrier_post(unsigned* bar, volatile LAS unsigned* st) {
    XcdBarrier b; b.bar = bar; b.x = xb_xcc_id(); b.st = st;
    if (threadIdx.x == 0) (void)xb_add(&bar[XB_XCNT(b.x)], 1u);
    return b;
}
__device__ __forceinline__ void xcd_barrier_complete(unsigned* bar, unsigned x, unsigned& nloc, unsigned& nx) {
    const unsigned G = gridDim.x * gridDim.y * gridDim.z;
    unsigned sum, cnt, mine, sp = 0u;
    for (;;) {
        sum = 0u; cnt = 0u; mine = 0u;
#pragma unroll
        for (unsigned j = 0; j < 16; ++j) { const unsigned c = xb_ld(&bar[XB_XCNT(j)]); sum += c; cnt += (c > 0u) ? 1u : 0u; mine = (j == x) ? c : mine; }
        if (sum == G) break;
        __builtin_amdgcn_s_sleep(1);
        if ((++sp & 255u) == 0u) { if (xb_ld(&bar[XB_TMO])) break; if (sp > XB_SPIN_CAP) { atomicAdd(&bar[XB_TMO], 1u); break; } }
    }
    nloc = mine > 0u ? mine : 1u; nx = cnt > 0u ? cnt : 1u;
}
__device__ __forceinline__ void xcd_barrier(const XcdBarrier& b) {
    asm volatile("s_waitcnt vmcnt(0)" ::: "memory");
    __syncthreads();
    if (threadIdx.x == 0) {
        unsigned* bar = b.bar;
        __builtin_amdgcn_s_waitcnt(0);
        unsigned nloc = b.st[0], nx = b.st[1];
        if (nloc == 0u) { xcd_barrier_complete(bar, b.x, nloc, nx); b.st[0] = nloc; b.st[1] = nx; }
        const unsigned old = xb_add(&bar[XB_XSUB(b.x)], 1u);
        const unsigned gen = old / nloc;
        if (old + 1u == (gen + 1u) * nloc) {
            __builtin_amdgcn_fence(__ATOMIC_RELEASE, "agent");
            asm volatile("s_waitcnt vmcnt(0)" ::: "memory");
            const unsigned og = xb_add(&bar[XB_TOP], 1u);
            const unsigned tg = og / nx;
            if (og + 1u == (tg + 1u) * nx) xb_add(&bar[XB_TOPGEN], 1u);
            else XB_SPIN(xb_ld(&bar[XB_TOPGEN]) == tg, bar);
            __builtin_amdgcn_fence(__ATOMIC_ACQUIRE, "agent");
            xb_add(&bar[XB_XGEN(b.x)], 1u);
            asm volatile("s_waitcnt vmcnt(0)" ::: "memory");
        } else {
            XB_SPIN(xb_ld(&bar[XB_XGEN(b.x)]) == gen, bar);
            __builtin_amdgcn_fence(__ATOMIC_ACQUIRE, "agent");
            asm volatile("s_waitcnt vmcnt(0)" ::: "memory");
        }
    }
    __syncthreads();
}

struct Frame {
    LAS unsigned char* lds;
    volatile LAS unsigned* MISC;
    gu32* ctl;
    int tid, lane, wave;
    int G;
    unsigned char* ws;
    float* out;
};
enum { I_X = 0, I_NORMG, I_FFN_IN, I_FFN_OUT, I_ML_IN, I_ML_IB, I_ML_FB, I_ML_HG, I_ML_OUT, I_GD_IN, I_GD_CONV, I_GD_ALOG, I_GD_DTB, I_GD_NG, I_GD_OUT };
constexpr int PTR_OFF = MISC_OFF + 128;
static_assert(PTR_OFF + 15 * 8 <= LDS_BYTES, "LDS map");
__device__ __forceinline__ const float* inp(const Frame& F, int i) {
    volatile LAS unsigned* p = (volatile LAS unsigned*)(F.lds + PTR_OFF) + 2 * i;
    const unsigned lo = __builtin_amdgcn_readfirstlane(p[0]), hi = __builtin_amdgcn_readfirstlane(p[1]);
    return (const float*)(((unsigned long long)hi << 32) | lo);
}
__device__ __forceinline__ void relaunder(Frame& F) { int t = threadIdx.x; asm volatile("" : "+v"(t)); F.tid = t; F.lane = t & 63; F.wave = __builtin_amdgcn_readfirstlane(t >> 6); }

__device__ __forceinline__ float wave_sum(float v) {
#pragma unroll
    for (int o = 1; o < 64; o <<= 1) v += __shfl_xor(v, o);
    return v;
}

__device__ __forceinline__ void tr_item(const float* W, int ldw, bf16* WT, int K, LAS float* scr, int lane) {
#pragma unroll 8
    for (int i = 0; i < 32; ++i) { const int kk = 2 * i + (lane >> 5); scr[kk * 33 + (lane & 31)] = ((const GAS float*)W)[(size_t)kk * ldw + (lane & 31)]; }
    LDS_WAIT(); asm volatile("" ::: "memory");
    const int c = lane & 7;
#pragma unroll
    for (int j = 0; j < 4; ++j) { const int n = (lane >> 3) + 8 * j; const LAS float* s = scr + (8 * c) * 33 + n;
        v4u o; o.x = pk2(s[0 * 33], s[1 * 33]); o.y = pk2(s[2 * 33], s[3 * 33]); o.z = pk2(s[4 * 33], s[5 * 33]); o.w = pk2(s[6 * 33], s[7 * 33]);
        *(GAS v4u*)(WT + (size_t)n * K + 8 * c) = o; }
    LDS_WAIT(); asm volatile("" ::: "memory");
}

__device__ __forceinline__ void row_store_hn(const f32x4 (&h)[8], const float* gain, bf16* orow, int lane) {
    float ss = 0.f;
#pragma unroll
    for (int j = 0; j < 8; ++j) ss += (h[j].x * h[j].x + h[j].y * h[j].y) + (h[j].z * h[j].z + h[j].w * h[j].w);
    const float rstd = 1.0f / sqrtf(wave_sum(ss) * (1.0f / D) + EPS);
    GAS v2u* o8 = (GAS v2u*)orow + lane;
    const GAS f32x4* gp = (const GAS f32x4*)gain + lane;
#pragma unroll
    for (int j = 0; j < 8; ++j) { const f32x4 g = gp[64 * j]; v2u w; w.x = pk2(h[j].x * rstd * g.x, h[j].y * rstd * g.y); w.y = pk2(h[j].z * rstd * g.z, h[j].w * rstd * g.w); o8[64 * j] = w; }
}

__device__ __forceinline__ void prologue(Frame& F) {
    LAS float* scr = (LAS float*)(F.lds + RING_OFF + F.wave * 16384);
    const int gw = blockIdx.x * NWAVES + F.wave, NGW = F.G * NWAVES;
    constexpr int I_A = 32 * 344, I_B = 86 * 64, I_C = 32 * 192, I_D = 32 * 64, I_E = 32 * 384, I_F = 64 * 64;
    constexpr int NITEMS = 8 * I_A + 8 * I_B + 2 * I_C + 2 * I_D + 2 * I_E + 2 * I_F;
    for (int it = gw; it < NITEMS; it += NGW) {
        int r = it;
        if (r < 8 * I_A) { const int inst = r / I_A; r -= inst * I_A; const int kb = r / 344, nb = r % 344; const int n0 = 32 * nb;
            const int nn = n0 < DFF ? n0 : n0 - DFF; const int drow = 256 * (nn / 128) + (nn % 128) + (n0 < DFF ? 0 : 128);
            tr_item(inp(F, I_FFN_IN) + (size_t)inst * D * NFF1 + (size_t)(64 * kb) * NFF1 + n0, NFF1, (bf16*)(F.ws + WS_W1 + inst * SZ_W1) + (size_t)drow * D + 64 * kb, D, scr, F.lane); continue; }
        r -= 8 * I_A;
        if (r < 8 * I_B) { const int inst = r / I_B; r -= inst * I_B; const int kb = r / 64, nb = r % 64;
            tr_item(inp(F, I_FFN_OUT) + (size_t)inst * DFF * D + (size_t)(64 * kb) * D + 32 * nb, D, (bf16*)(F.ws + WS_W2 + inst * SZ_W2) + (size_t)(32 * nb) * DFF + 64 * kb, DFF, scr, F.lane); continue; }
        r -= 8 * I_B;
        if (r < 2 * I_C) { const int inst = r / I_C; r -= inst * I_C; const int kb = r / 192, nb = r % 192;
            tr_item(inp(F, I_ML_IN) + (size_t)inst * D * ML_IN + (size_t)(64 * kb) * ML_IN + 32 * nb, ML_IN, (bf16*)(F.ws + WS_MLIN + inst * SZ_MLIN) + (size_t)(32 * nb) * D + 64 * kb, D, scr, F.lane); continue; }
        r -= 2 * I_C;
        if (r < 2 * I_D) { const int inst = r / I_D; r -= inst * I_D; const int kb = r / 64, nb = r % 64;
            tr_item(inp(F, I_ML_OUT) + (size_t)inst * ML_V * D + (size_t)(64 * kb) * D + 32 * nb, D, (bf16*)(F.ws + WS_MLOUT + inst * SZ_MLOUT) + (size_t)(32 * nb) * ML_V + 64 * kb, ML_V, scr, F.lane); continue; }
        r -= 2 * I_D;
        if (r < 2 * I_E) { const int inst = r / I_E; r -= inst * I_E; const int kb = r / 384, nb = r % 384;
            tr_item(inp(F, I_GD_IN) + (size_t)inst * D * GD_IN + (size_t)(64 * kb) * GD_IN + 32 * nb, GD_IN, (bf16*)(F.ws + WS_GDIN + inst * SZ_GDIN) + (size_t)(32 * nb) * D + 64 * kb, D, scr, F.lane); continue; }
        r -= 2 * I_E;
        { const int inst = r / I_F; r -= inst * I_F; const int kb = r / 64, nb = r % 64;
            tr_item(inp(F, I_GD_OUT) + (size_t)inst * GD_VTOT * D + (size_t)(64 * kb) * D + 32 * nb, D, (bf16*)(F.ws + WS_GDOUT + inst * SZ_GDOUT) + (size_t)(32 * nb) * GD_VTOT + 64 * kb, GD_VTOT, scr, F.lane); }
    }
    { const int gt = blockIdx.x * (NWAVES * 64) + F.tid, NGT = F.G * NWAVES * 64;
      for (int i = gt; i < 2 * 16 * D; i += NGT) { const int inst = i / (16 * D), rr = (i / D) % 16, k = i % D;
          const float v = rr < 8 ? inp(F, I_ML_IN)[(size_t)inst * D * ML_IN + (size_t)k * ML_IN + ML_N + rr] : 0.f; ((bf16*)(F.ws + WS_MLX))[i] = (bf16)f2bf(v); }
      for (int i = gt; i < 2 * 64 * D; i += NGT) { const int inst = i / (64 * D), rr = (i / D) % 64, k = i % D;
          ((bf16*)(F.ws + WS_GDX))[i] = (bf16)f2bf(inp(F, I_GD_IN)[(size_t)inst * D * GD_IN + (size_t)k * GD_IN + GD_N + rr]); } }
    for (int m = gw; m < M; m += NGW) {
        const GAS f32x4* xr = (const GAS f32x4*)(inp(F, I_X) + (size_t)m * D) + F.lane; GAS f32x4* hr = (GAS f32x4*)(F.out + (size_t)m * D) + F.lane;
        f32x4 h[8];
#pragma unroll
        for (int j = 0; j < 8; ++j) { h[j] = xr[64 * j]; hr[64 * j] = h[j]; }
        row_store_hn(h, inp(F, I_NORMG), (bf16*)(F.ws + WS_HN) + (size_t)m * D, F.lane);
    }
}

__device__ __forceinline__ void norm_phase(Frame& F, float alpha, const float* gpost, const float* gpre, bool write_hn) {
    const int gw = blockIdx.x * NWAVES + F.wave, NGW = F.G * NWAVES;
    const float* Y = (const float*)(F.ws + WS_Y);
    for (int m = gw; m < M; m += NGW) {
        const GAS f32x4* yr = (const GAS f32x4*)(Y + (size_t)m * D) + F.lane; GAS f32x4* hr = (GAS f32x4*)(F.out + (size_t)m * D) + F.lane;
        const GAS f32x4* gp = (const GAS f32x4*)gpost + F.lane;
        f32x4 y[8], h[8]; float ss = 0.f;
#pragma unroll
        for (int j = 0; j < 8; ++j) { y[j] = yr[64 * j]; h[j] = hr[64 * j]; ss += (y[j].x * y[j].x + y[j].y * y[j].y) + (y[j].z * y[j].z + y[j].w * y[j].w); }
        const float rs = alpha / sqrtf(wave_sum(ss) * (1.0f / D) + EPS);
#pragma unroll
        for (int j = 0; j < 8; ++j) { const f32x4 g = gp[64 * j]; h[j] = h[j] + (y[j] * rs) * g; hr[64 * j] = h[j]; }
        if (write_hn) row_store_hn(h, gpre, (bf16*)(F.ws + WS_HN) + (size_t)m * D, F.lane);
    }
}

template <int NT> __device__ __forceinline__ void skinny_phase(Frame& F, const bf16* Wx, float* out) {
    const int gw = blockIdx.x * NWAVES + F.wave, NGW = F.G * NWAVES; const int lane = F.lane, fr = lane & 15, fq = lane >> 4;
    const bf16* A = (const bf16*)(F.ws + WS_HN);
    for (int u = gw; u < M / 16; u += NGW) {
        f32x4 acc[NT];
#pragma unroll
        for (int n = 0; n < NT; ++n) acc[n] = (f32x4){0.f, 0.f, 0.f, 0.f};
        const bf16* ap = A + (size_t)(16 * u + fr) * D + fq * 8; const bf16* bp = Wx + (size_t)fr * D + fq * 8;
#pragma unroll 4
        for (int ks = 0; ks < D / 32; ++ks) {
            const bf16x8 a = *(const GAS bf16x8*)(ap + ks * 32);
#pragma unroll
            for (int n = 0; n < NT; ++n) { const bf16x8 b = *(const GAS bf16x8*)(bp + (size_t)n * 16 * D + ks * 32); acc[n] = __builtin_amdgcn_mfma_f32_16x16x32_bf16(a, b, acc[n], 0, 0, 0); }
        }
#pragma unroll
        for (int n = 0; n < NT; ++n)
#pragma unroll
            for (int j = 0; j < 4; ++j) out[(size_t)(16 * u + fq * 4 + j) * (16 * NT) + n * 16 + fr] = acc[n][j];
    }
}

__device__ __forceinline__ float softcap15(float x) { return 15.0f * tanhf(x * (1.0f / 15.0f)); }
__device__ __forceinline__ float logsigmoid_f(float x) { return x >= 0.f ? -log1pf(expf(-x)) : x - log1pf(expf(x)); }
__device__ __forceinline__ float softplus_f(float x) { return x > 20.f ? x : log1pf(expf(x)); }
__device__ __forceinline__ float sigmoid_f(float x) { return 1.0f / (1.0f + expf(-x)); }

__device__ __forceinline__ void ml_scan_slow(Frame& F, int j) {
    LAS float* qT = (LAS float*)(F.lds);
    LAS float* kT = qT + 16 * 256;
    LAS float* vT = kT + 16 * 256;
    LAS float* fwS = vT + 16 * 32;
    LAS float* iwS = fwS + 16;
    LAS float* emS = iwS + 16;
    LAS float* red = emS + 16;
    LAS float* redd = red + 2 * 16 * 32;
    const bf16* P = (const bf16*)(F.ws + WS_PROJ); const float* GT = (const float*)(F.ws + WS_GATES); float* O = (float*)(F.ws + WS_SCAN);
    const int tid = F.tid, e = tid & 31, dg = tid >> 5, d0 = 16 * dg;
    for (int item = blockIdx.x; item < BATCH * ML_H * 16; item += F.G) {
        const int b = item / (ML_H * 16), hh = (item / 16) % ML_H, sl = item % 16;
        const float ib = inp(F, I_ML_IB)[j * ML_H + hh], fb = inp(F, I_ML_FB)[j * ML_H + hh];
        float C[16], n[16]; float mcar = 0.f;
#pragma unroll
        for (int i = 0; i < 16; ++i) { C[i] = 0.f; n[i] = 0.f; }
        for (int t0 = 0; t0 < SEQ; t0 += 16) {
            __syncthreads();
            const size_t row0 = (size_t)b * SEQ + t0;
            for (int o = tid; o < 16 * 256; o += 512) { const int r = o >> 8, c = o & 255;
                qT[o] = bf2f(P[(row0 + r) * ML_N + hh * ML_DQK + c]) * 0.0625f; kT[o] = bf2f(P[(row0 + r) * ML_N + ML_QK + hh * ML_DQK + c]); }
            { const int r = tid >> 5, c = tid & 31; vT[tid] = bf2f(P[(row0 + r) * ML_N + 2 * ML_QK + hh * ML_DV + sl * 32 + c]); }
            if (tid == 0) {
                float m = mcar;
                for (int s = 0; s < 16; ++s) { const float il = softcap15(GT[(row0 + s) * 16 + hh] + ib); const float fl = logsigmoid_f(softcap15(GT[(row0 + s) * 16 + 4 + hh] + fb));
                    const float mn = fmaxf(fl + m, il); fwS[s] = expf(fl + m - mn); iwS[s] = expf(il - mn); emS[s] = expf(-mn); m = mn; }
                mcar = m;
            }
            __syncthreads();
            for (int s = 0; s < 16; ++s) {
                const float f = fwS[s], iw = iwS[s], v = vT[s * 32 + e]; float pn = 0.f, pd = 0.f;
#pragma unroll
                for (int i = 0; i < 16; ++i) { const float kk = kT[s * 256 + d0 + i] * iw, qq = qT[s * 256 + d0 + i]; C[i] = f * C[i] + kk * v; n[i] = f * n[i] + kk; pn += qq * C[i]; pd += qq * n[i]; }
                red[((s & 1) * 16 + dg) * 32 + e] = pn; if (e == 0) redd[(s & 1) * 16 + dg] = pd;
                __syncthreads();
                if (tid < 32) { float num = 0.f, den = 0.f;
#pragma unroll
                    for (int g = 0; g < 16; ++g) { num += red[((s & 1) * 16 + g) * 32 + tid]; den += redd[(s & 1) * 16 + g]; }
                    O[(row0 + s) * ML_V + hh * ML_DV + sl * 32 + tid] = num / fmaxf(fabsf(den), emS[s]); }
            }
        }
    }
}

__device__ __forceinline__ bf16x8 ldsfrag(const LAS unsigned char* base, int row, int pitchB, int kbyte) { return *(const LAS bf16x8*)(base + row * pitchB + kbyte); }
__device__ __forceinline__ float wave_max(float v) {
#pragma unroll
    for (int o = 1; o < 64; o <<= 1) v = fmaxf(v, __shfl_xor(v, o));
    return v;
}
__device__ __forceinline__ void ml_scan_fast(Frame& F, int j) {
    constexpr int PQ = 528, PS = 144;
    LAS unsigned char* Qs = F.lds;
    LAS unsigned char* Ks = Qs + 36864;
    LAS unsigned char* VT = Ks + 33792;
    LAS unsigned char* CT = VT + 6912;
    LAS unsigned char* Ss = CT + 25344;
    LAS float* gU1 = (LAS float*)(Ss + 9216);
    LAS float* gU2 = gU1 + 64;
    LAS float* gInter = gU2 + 64;
    LAS float* gEm = gInter + 64;
    LAS float* gW = gEm + 64;
    LAS float* gDecay = gW + 64;
    const bf16* P = (const bf16*)(F.ws + WS_PROJ); const float* GT = (const float*)(F.ws + WS_GATES); float* O = (float*)(F.ws + WS_SCAN);
    const int tid = F.tid, lane = F.lane, w = F.wave, fr = lane & 15, fq = lane >> 4;
    for (int item = blockIdx.x; item < BATCH * ML_H * 16; item += F.G) {
        const int b = item / (ML_H * 16), hh = (item / 16) % ML_H, sl = item % 16;
        const float ib = inp(F, I_ML_IB)[j * ML_H + hh], fb = inp(F, I_ML_FB)[j * ML_H + hh];
        __syncthreads();
        for (int o = tid; o < 25344 / 4; o += 512) ((LAS unsigned*)CT)[o] = 0u;
        for (int o = tid; o < 16 * 36; o += 512) ((LAS unsigned*)(VT + 32 * PS))[o] = (o < 36) ? 0x3F803F80u : 0u;
        f32x4 Cacc[2][3];
#pragma unroll
        for (int a = 0; a < 2; ++a)
#pragma unroll
            for (int c = 0; c < 3; ++c) Cacc[a][c] = (f32x4){0.f, 0.f, 0.f, 0.f};
        float mcar = 0.f;
        v4u qreg[4], kreg[4], vreg; float ipre, fpre;
        const size_t rowb = (size_t)b * SEQ;
#define ML_PREFETCH(c_) do { const size_t r0_ = rowb + (size_t)(c_) * 64; \
            _Pragma("unroll") for (int i_ = 0; i_ < 4; ++i_) { const int p_ = tid + 512 * i_, rr_ = p_ >> 5, sg_ = p_ & 31; \
                qreg[i_] = *(const GAS v4u*)(P + (r0_ + rr_) * ML_N + hh * ML_DQK + sg_ * 8); kreg[i_] = *(const GAS v4u*)(P + (r0_ + rr_) * ML_N + ML_QK + hh * ML_DQK + sg_ * 8); } \
            if (tid < 256) vreg = *(const GAS v4u*)(P + (r0_ + (tid >> 2)) * ML_N + 2 * ML_QK + hh * ML_DV + sl * 32 + (tid & 3) * 8); \
            if (w == 0) { ipre = GT[(r0_ + lane) * 16 + hh]; fpre = GT[(r0_ + lane) * 16 + 4 + hh]; } } while (0)
        ML_PREFETCH(0);
        for (int c = 0; c < SEQ / 64; ++c) {
            const size_t row0 = rowb + (size_t)c * 64;
#pragma unroll
            for (int i = 0; i < 4; ++i) { const int p = tid + 512 * i, rr = p >> 5, sg = p & 31; *(LAS v4u*)(Qs + rr * PQ + sg * 16) = qreg[i]; *(LAS v4u*)(Ks + rr * PQ + sg * 16) = kreg[i]; }
            if (tid < 256) { const int rr = tid >> 2, e0 = (tid & 3) * 8; const unsigned vv[4] = {vreg.x, vreg.y, vreg.z, vreg.w};
#pragma unroll
                for (int i = 0; i < 4; ++i) { *(LAS unsigned short*)(VT + (e0 + 2 * i) * PS + rr * 2) = (unsigned short)(vv[i] & 0xffffu); *(LAS unsigned short*)(VT + (e0 + 2 * i + 1) * PS + rr * 2) = (unsigned short)(vv[i] >> 16); } }
            if (w == 0) {
                const float il = softcap15(ipre + ib), fl = logsigmoid_f(softcap15(fpre + fb));
                float bc = fl;
#pragma unroll
                for (int o = 1; o < 64; o <<= 1) { const float y = __shfl_up(bc, o); if (lane >= o) bc += y; }
                const float u2 = il - bc; float pm = u2;
#pragma unroll
                for (int o = 1; o < 64; o <<= 1) { const float y = __shfl_up(pm, o); if (lane >= o) pm = fmaxf(pm, y); }
                const float blast = __shfl(bc, 63);
                const float linter = bc + mcar, mt = fmaxf(linter, bc + pm);
                gU1[lane] = bc - mt - 2.772588722239781f; gU2[lane] = u2; gInter[lane] = expf(linter - mt) * 0.0625f; gEm[lane] = expf(-mt);
                const float lw = blast + u2; const float mnew = fmaxf(blast + mcar, wave_max(lw));
                gW[lane] = expf(lw - mnew); if (lane == 0) gDecay[0] = expf(blast + mcar - mnew);
                mcar = mnew;
            }
            if (c + 1 < SEQ / 64) ML_PREFETCH(c + 1);
            __syncthreads();
            { const int lt = w >> 1, ct0 = 2 * (w & 1); f32x4 sa0 = (f32x4){0.f, 0.f, 0.f, 0.f}, sa1 = sa0;
#pragma unroll
              for (int ks = 0; ks < 8; ++ks) { const bf16x8 a = ldsfrag(Qs, lt * 16 + fr, PQ, ks * 64 + fq * 16), b0 = ldsfrag(Ks, ct0 * 16 + fr, PQ, ks * 64 + fq * 16), b1 = ldsfrag(Ks, (ct0 + 1) * 16 + fr, PQ, ks * 64 + fq * 16);
                  sa0 = __builtin_amdgcn_mfma_f32_16x16x32_bf16(a, b0, sa0, 0, 0, 0); sa1 = __builtin_amdgcn_mfma_f32_16x16x32_bf16(a, b1, sa1, 0, 0, 0); }
#pragma unroll
              for (int t = 0; t < 2; ++t) { const int sp = (ct0 + t) * 16 + fr; const float u2 = gU2[sp];
#pragma unroll
                  for (int jj = 0; jj < 4; ++jj) { const int l = lt * 16 + fq * 4 + jj; const float sv = (t == 0 ? sa0[jj] : sa1[jj]); const float val = sp <= l ? sv * expf(gU1[l] + u2) : 0.f;
                      *(LAS unsigned short*)(Ss + l * PS + sp * 2) = (unsigned short)f2bf(val); } } }
            __syncthreads();
            { const int lt = w >> 1, et = w & 1; f32x4 n0 = (f32x4){0.f, 0.f, 0.f, 0.f}, n1 = n0;
#pragma unroll
              for (int ks = 0; ks < 8; ++ks) { const bf16x8 a = ldsfrag(Qs, lt * 16 + fr, PQ, ks * 64 + fq * 16), b0 = ldsfrag(CT, et * 16 + fr, PQ, ks * 64 + fq * 16), b1 = ldsfrag(CT, 32 + fr, PQ, ks * 64 + fq * 16);
                  n0 = __builtin_amdgcn_mfma_f32_16x16x32_bf16(a, b0, n0, 0, 0, 0); n1 = __builtin_amdgcn_mfma_f32_16x16x32_bf16(a, b1, n1, 0, 0, 0); }
#pragma unroll
              for (int jj = 0; jj < 4; ++jj) { const float it = gInter[lt * 16 + fq * 4 + jj]; n0[jj] *= it; n1[jj] *= it; }
#pragma unroll
              for (int ks = 0; ks < 2; ++ks) { const bf16x8 a = ldsfrag(Ss, lt * 16 + fr, PS, ks * 64 + fq * 16), b0 = ldsfrag(VT, et * 16 + fr, PS, ks * 64 + fq * 16), b1 = ldsfrag(VT, 32 + fr, PS, ks * 64 + fq * 16);
                  n0 = __builtin_amdgcn_mfma_f32_16x16x32_bf16(a, b0, n0, 0, 0, 0); n1 = __builtin_amdgcn_mfma_f32_16x16x32_bf16(a, b1, n1, 0, 0, 0); }
#pragma unroll
              for (int jj = 0; jj < 4; ++jj) { const int l = lt * 16 + fq * 4 + jj; const float den = __shfl(n1[jj], lane & 48);
                  O[(row0 + l) * ML_V + hh * ML_DV + sl * 32 + et * 16 + fr] = n0[jj] / fmaxf(fabsf(den), gEm[l]); } }
            __syncthreads();
            { const float ws = gW[lane];
#pragma unroll
              for (int g = 0; g < 4; ++g) { const int d0 = 32 * w + 8 * g; const v4u kk = *(const LAS v4u*)(Ks + lane * PQ + d0 * 2); const unsigned kv[4] = {kk.x, kk.y, kk.z, kk.w};
#pragma unroll
                  for (int i = 0; i < 4; ++i) { *(LAS unsigned short*)(Qs + (d0 + 2 * i) * PS + lane * 2) = (unsigned short)f2bf(bflo(kv[i]) * ws); *(LAS unsigned short*)(Qs + (d0 + 2 * i + 1) * PS + lane * 2) = (unsigned short)f2bf(bfhi(kv[i]) * ws); } } }
            __syncthreads();
            { const float dc = gDecay[0];
#pragma unroll
              for (int a = 0; a < 2; ++a)
#pragma unroll
                  for (int e = 0; e < 3; ++e) Cacc[a][e] = Cacc[a][e] * dc;
#pragma unroll
              for (int ks = 0; ks < 2; ++ks) { const bf16x8 a0 = ldsfrag(Qs, (2 * w) * 16 + fr, PS, ks * 64 + fq * 16), a1 = ldsfrag(Qs, (2 * w + 1) * 16 + fr, PS, ks * 64 + fq * 16);
#pragma unroll
                  for (int e = 0; e < 3; ++e) { const bf16x8 bb = ldsfrag(VT, e * 16 + fr, PS, ks * 64 + fq * 16);
                      Cacc[0][e] = __builtin_amdgcn_mfma_f32_16x16x32_bf16(a0, bb, Cacc[0][e], 0, 0, 0); Cacc[1][e] = __builtin_amdgcn_mfma_f32_16x16x32_bf16(a1, bb, Cacc[1][e], 0, 0, 0); } }
#pragma unroll
              for (int a = 0; a < 2; ++a)
#pragma unroll
                  for (int e = 0; e < 3; ++e) { const f32x4 v = Cacc[a][e]; v2u pk; pk.x = pk2(v[0], v[1]); pk.y = pk2(v[2], v[3]);
                      *(LAS v2u*)(CT + (e * 16 + fr) * PQ + ((2 * w + a) * 16 + fq * 4) * 2) = pk; } }
            __syncthreads();
        }
#undef ML_PREFETCH
    }
}

__device__ __forceinline__ void ml_gate_phase(Frame& F, int j) {
    const int gw = blockIdx.x * NWAVES + F.wave, NGW = F.G * NWAVES;
    const float* S = (const float*)(F.ws + WS_SCAN); const bf16* P = (const bf16*)(F.ws + WS_PROJ); bf16* Yo = (bf16*)(F.ws + WS_YMIX);
    for (int m = gw; m < M; m += NGW) {
#pragma unroll
        for (int hh = 0; hh < ML_H; ++hh) {
            const GAS f32x4* sr = (const GAS f32x4*)(S + (size_t)m * ML_V + hh * ML_DV) + F.lane;
            const f32x4 a = sr[0], c = sr[64];
            const float ss = wave_sum((a.x * a.x + a.y * a.y) + (a.z * a.z + a.w * a.w) + (c.x * c.x + c.y * c.y) + (c.z * c.z + c.w * c.w));
            const float rstd = 1.0f / sqrtf(ss * (1.0f / ML_DV) + EPS);
            const GAS f32x4* gp = (const GAS f32x4*)(inp(F, I_ML_HG) + (size_t)(j * ML_H + hh) * ML_DV) + F.lane;
            const GAS v2u* op = (const GAS v2u*)(P + (size_t)m * ML_N + 2 * ML_QK + ML_V + hh * ML_DV) + F.lane;
            GAS v2u* yp = (GAS v2u*)(Yo + (size_t)m * ML_V + hh * ML_DV) + F.lane;
            { const f32x4 g = gp[0]; const v2u o = op[0]; v2u w;
              w.x = pk2(sigmoid_f(bflo(o.x)) * a.x * rstd * g.x, sigmoid_f(bfhi(o.x)) * a.y * rstd * g.y); w.y = pk2(sigmoid_f(bflo(o.y)) * a.z * rstd * g.z, sigmoid_f(bfhi(o.y)) * a.w * rstd * g.w); yp[0] = w; }
            { const f32x4 g = gp[64]; const v2u o = op[64]; v2u w;
              w.x = pk2(sigmoid_f(bflo(o.x)) * c.x * rstd * g.x, sigmoid_f(bfhi(o.x)) * c.y * rstd * g.y); w.y = pk2(sigmoid_f(bflo(o.y)) * c.z * rstd * g.z, sigmoid_f(bfhi(o.y)) * c.w * rstd * g.w); yp[64] = w; }
        }
    }
}

__device__ __forceinline__ void gdn_scan_slow(Frame& F, int j) {
    LAS float* qT = (LAS float*)(F.lds);
    LAS float* kT = qT + 16 * 128;
    LAS float* vT = kT + 16 * 128;
    LAS float* btS = vT + 16 * 64;
    LAS float* agS = btS + 16;
    LAS float* qsS = agS + 16;
    LAS float* ksS = qsS + 16;
    LAS float* red1 = ksS + 16;
    LAS float* red2 = red1 + 2 * 8 * 64;
    const bf16* P = (const bf16*)(F.ws + WS_PROJ); const float* GT = (const float*)(F.ws + WS_GATES); float* O = (float*)(F.ws + WS_SCAN);
    const float* CW = inp(F, I_GD_CONV) + (size_t)j * 4 * GD_CONVCH;
    const int tid = F.tid, e = tid & 63, dg = tid >> 6, d0 = 16 * dg;
    for (int item = blockIdx.x; item < BATCH * GD_HV * 2; item += F.G) {
        const int b = item / (GD_HV * 2), hv = (item >> 1) % GD_HV, half = item & 1, hk = hv >> 1;
        const float Aexp = expf(inp(F, I_GD_ALOG)[j * GD_HV + hv]), dtb = inp(F, I_GD_DTB)[j * GD_HV + hv];
        float S[16];
#pragma unroll
        for (int i = 0; i < 16; ++i) S[i] = 0.f;
        for (int t0 = 0; t0 < SEQ; t0 += 16) {
            __syncthreads();
            const size_t row0 = (size_t)b * SEQ + t0;
            for (int o = tid; o < 5120; o += 512) {
                int r, ch; LAS float* dst;
                if (o < 2048) { r = o >> 7; ch = hk * 128 + (o & 127); dst = qT + o; }
                else if (o < 4096) { r = (o - 2048) >> 7; ch = 2048 + hk * 128 + (o & 127); dst = kT + (o - 2048); }
                else { r = (o - 4096) >> 6; ch = 4096 + hv * 128 + half * 64 + (o & 63); dst = vT + (o - 4096); }
                float acc = 0.f;
#pragma unroll
                for (int tp = 0; tp < 4; ++tp) { const int t = t0 + r - 3 + tp; if (t >= 0) acc += CW[tp * GD_CONVCH + ch] * bf2f(P[((size_t)b * SEQ + t) * GD_N + ch]); }
                *dst = acc * sigmoid_f(acc);
            }
            if (tid < 16) { const float bp = GT[(row0 + tid) * 64 + hv], ap = GT[(row0 + tid) * 64 + 32 + hv];
                btS[tid] = sigmoid_f(bp); agS[tid] = expf(-Aexp * softplus_f(ap + dtb)); }
            __syncthreads();
#pragma unroll
            for (int i = 0; i < 4; ++i) { const int id = 4 * F.wave + i, isk = id >> 4, r = id & 15; const LAS float* arr = (isk ? kT : qT) + r * 128;
                const float x0 = arr[F.lane], x1 = arr[F.lane + 64]; const float ss = wave_sum(x0 * x0 + x1 * x1); const float sc = 1.0f / sqrtf(ss + EPS);
                if (F.lane == 0) { if (isk) ksS[r] = sc; else qsS[r] = sc * 0.08838834764831845f; } }
            __syncthreads();
            for (int s = 0; s < 16; ++s) {
                const float a = agS[s], bt = btS[s], ks = ksS[s], qs = qsS[s]; float p = 0.f;
#pragma unroll
                for (int i = 0; i < 16; ++i) { S[i] *= a; p += kT[s * 128 + d0 + i] * S[i]; }
                red1[((s & 1) * 8 + dg) * 64 + e] = p * ks;
                __syncthreads();
                float kS = 0.f;
#pragma unroll
                for (int g = 0; g < 8; ++g) kS += red1[((s & 1) * 8 + g) * 64 + e];
                const float vn = bt * (vT[s * 64 + e] - kS) * ks; float oo = 0.f;
#pragma unroll
                for (int i = 0; i < 16; ++i) { S[i] += kT[s * 128 + d0 + i] * vn; oo += qT[s * 128 + d0 + i] * S[i]; }
                red2[((s & 1) * 8 + dg) * 64 + e] = oo * qs;
                __syncthreads();
                if (tid < 64) { float r = 0.f;
#pragma unroll
                    for (int g = 0; g < 8; ++g) r += red2[((s & 1) * 8 + g) * 64 + tid];
                    O[(row0 + s) * GD_VTOT + hv * 128 + half * 64 + tid] = r; }
            }
        }
    }
}

__device__ __forceinline__ f32x4 mm16_f32(f32x4 acc, const LAS float* A, int lda, const LAS float* B, int ldb, int K, int fr, int fq) {
#pragma unroll
    for (int k0 = 0; k0 < K; k0 += 4) { const float a = A[fr * lda + k0 + fq]; const float b = B[(k0 + fq) * ldb + fr]; acc = __builtin_amdgcn_mfma_f32_16x16x4f32(a, b, acc, 0, 0, 0); }
    return acc;
}
__device__ __forceinline__ void gdn_scan_fast(Frame& F, int j) {
    constexpr int P8 = 272, P4 = 144;
    LAS unsigned char* const L0 = F.lds;
    LAS float* AM = (LAS float*)(L0);
    LAS unsigned char* TBb = L0, * T2b = L0 + 9216;
    LAS float* TM = (LAS float*)(L0 + 18432);
    LAS unsigned char* VN2 = L0 + 18432;
    LAS float* XM = (LAS float*)(L0 + 35072);
    LAS unsigned char* QU = L0 + 39296;
    LAS unsigned char* KU = QU + 17408;
    LAS unsigned char* KUT = KU + 17408;
    LAS unsigned char* VBT = KUT + 18432;
    LAS unsigned char* QKM = VBT + 9216;
    LAS unsigned char* ST = QKM + 9216;
    LAS float* sGC = (LAS float*)(ST + 17408);
    LAS float* sBeta = sGC + 64; LAS float* sRq = sBeta + 64; LAS float* sRk = sRq + 64;
    static_assert(39296 + 17408 * 2 + 18432 + 9216 * 2 + 17408 + 1024 <= RING_BYTES, "gdn LDS map");
    const bf16* P = (const bf16*)(F.ws + WS_PROJ); const float* GT = (const float*)(F.ws + WS_GATES); float* O = (float*)(F.ws + WS_SCAN);
    const float* CW = inp(F, I_GD_CONV) + (size_t)j * 4 * GD_CONVCH;
    const int tid_o = F.tid, lane_o = F.lane, w = F.wave;
    for (int item = blockIdx.x; item < BATCH * GD_HV * 2; item += F.G) {
        const int b = item / (GD_HV * 2), hv = (item >> 1) % GD_HV, half = item & 1, hk = hv >> 1;
        const float Aexp = expf(inp(F, I_GD_ALOG)[j * GD_HV + hv]), dtb = inp(F, I_GD_DTB)[j * GD_HV + hv];
        const size_t rowb = (size_t)b * SEQ;
        const int rs = w < 6 ? (w % 3) * 21 : 16 * (2 * (w - 6) + (lane_o >> 5));
        const int chb = w < 3 ? hk * 128 + 2 * lane_o : (w < 6 ? 2048 + hk * 128 + 2 * lane_o : 4096 + hv * 128 + half * 64 + 2 * (lane_o & 31));
        float cw0[4], cw1[4];
#pragma unroll
        for (int tp = 0; tp < 4; ++tp) { cw0[tp] = CW[tp * GD_CONVCH + chb]; cw1[tp] = CW[tp * GD_CONVCH + chb + 1]; }
        __syncthreads();
        for (int o = tid_o; o < 17408 / 4; o += 512) ((LAS unsigned*)ST)[o] = 0u;
        f32x4 Sacc[4];
#pragma unroll
        for (int e = 0; e < 4; ++e) Sacc[e] = (f32x4){0.f, 0.f, 0.f, 0.f};
        unsigned xr[25]; float bp[16]; float ga = 0.f, gb = 0.f;
#define GD_PREFETCH(c_) do { const int lane = lane_o; const int tb_ = (c_) * 64 + rs - 3; const GAS unsigned char* pp_ = (const GAS unsigned char*)(P + (rowb + tb_) * GD_N + chb); \
            if (w < 6) { _Pragma("unroll") for (int i_ = 0; i_ < 25; ++i_) { const unsigned x_ = *(const GAS unsigned*)pp_; xr[i_] = (tb_ + i_ >= 0) ? x_ : 0u; pp_ += GD_N * 2; asm volatile("" : "+v"(pp_)); } } \
            else { _Pragma("unroll") for (int i_ = 0; i_ < 19; ++i_) { const unsigned x_ = *(const GAS unsigned*)pp_; xr[i_] = (tb_ + i_ >= 0) ? x_ : 0u; pp_ += GD_N * 2; asm volatile("" : "+v"(pp_)); } \
                   const GAS float* gp_ = (const GAS float*)(GT + (rowb + (c_) * 64 + rs) * 64 + hv); \
                   _Pragma("unroll") for (int i_ = 0; i_ < 16; ++i_) bp[i_] = gp_[i_ * 64]; \
                   if (w == 7) { ga = GT[(rowb + (c_) * 64 + lane) * 64 + 32 + hv]; gb = GT[(rowb + (c_) * 64 + lane) * 64 + hv]; } } } while (0)
        GD_PREFETCH(0);
        for (int c = 0; c < SEQ / 64; ++c) {
            int tid = tid_o; asm volatile("" : "+v"(tid)); const int lane = tid & 63, fr = lane & 15, fq = lane >> 4;
            const size_t row0 = rowb + (size_t)c * 64;
            if (w < 6) {
                const bool isk = w >= 3; LAS unsigned char* dst = isk ? KU : QU; LAS float* sR = isk ? sRk : sRq; const float sc0 = isk ? 1.0f : 0.08838834764831845f;
#pragma unroll
                for (int i = 0; i < 22; ++i) { const int r = rs + i; float y0 = 0.f, y1 = 0.f;
#pragma unroll
                    for (int tp = 0; tp < 4; ++tp) { y0 += cw0[tp] * bflo(xr[i + tp]); y1 += cw1[tp] * bfhi(xr[i + tp]); }
                    y0 = y0 * sigmoid_f(y0); y1 = y1 * sigmoid_f(y1);
                    const float ss = wave_sum(y0 * y0 + y1 * y1);
                    if (lane == 0) sR[r] = sc0 / sqrtf(ss + EPS);
                    const unsigned pk = pk2(y0, y1);
                    *(LAS unsigned*)(dst + r * P8 + lane * 4) = pk;
                    if (isk) { *(LAS unsigned short*)(KUT + (2 * lane) * P4 + r * 2) = (unsigned short)(pk & 0xffffu); *(LAS unsigned short*)(KUT + (2 * lane + 1) * P4 + r * 2) = (unsigned short)(pk >> 16); } }
            } else {
                const int vp = lane & 31;
#pragma unroll
                for (int i = 0; i < 16; ++i) { const int r = rs + i; float y0 = 0.f, y1 = 0.f;
#pragma unroll
                    for (int tp = 0; tp < 4; ++tp) { y0 += cw0[tp] * bflo(xr[i + tp]); y1 += cw1[tp] * bfhi(xr[i + tp]); }
                    const float bt = sigmoid_f(bp[i]);
                    y0 = y0 * sigmoid_f(y0) * bt; y1 = y1 * sigmoid_f(y1) * bt;
                    *(LAS unsigned short*)(VBT + (2 * vp) * P4 + r * 2) = (unsigned short)f2bf(y0); *(LAS unsigned short*)(VBT + (2 * vp + 1) * P4 + r * 2) = (unsigned short)f2bf(y1); }
                if (w == 7) { float g = -Aexp * softplus_f(ga + dtb);
#pragma unroll
                    for (int o = 1; o < 64; o <<= 1) { const float y = __shfl_up(g, o); if (lane >= o) g += y; }
                    sGC[lane] = g; sBeta[lane] = sigmoid_f(gb); }
            }
            if (c + 1 < SEQ / 64) GD_PREFETCH(c + 1);
            __syncthreads();
            { const int lt = w >> 1, ct0 = 2 * (w & 1); f32x4 kk0 = (f32x4){0.f, 0.f, 0.f, 0.f}, kk1 = kk0, qk0 = kk0, qk1 = kk0;
#pragma unroll
              for (int ks = 0; ks < 4; ++ks) { const bf16x8 aK = ldsfrag(KU, lt * 16 + fr, P8, ks * 64 + fq * 16), aQ = ldsfrag(QU, lt * 16 + fr, P8, ks * 64 + fq * 16);
                  const bf16x8 b0 = ldsfrag(KU, ct0 * 16 + fr, P8, ks * 64 + fq * 16), b1 = ldsfrag(KU, (ct0 + 1) * 16 + fr, P8, ks * 64 + fq * 16);
                  kk0 = __builtin_amdgcn_mfma_f32_16x16x32_bf16(aK, b0, kk0, 0, 0, 0); kk1 = __builtin_amdgcn_mfma_f32_16x16x32_bf16(aK, b1, kk1, 0, 0, 0);
                  qk0 = __builtin_amdgcn_mfma_f32_16x16x32_bf16(aQ, b0, qk0, 0, 0, 0); qk1 = __builtin_amdgcn_mfma_f32_16x16x32_bf16(aQ, b1, qk1, 0, 0, 0); }
#pragma unroll
              for (int t = 0; t < 2; ++t) { const int s = (ct0 + t) * 16 + fr; const float gs = sGC[s], rks = sRk[s];
#pragma unroll
                  for (int jj = 0; jj < 4; ++jj) { const int l = lt * 16 + fq * 4 + jj; const float e = s <= l ? expf(sGC[l] - gs) : 0.f;
                      const float kv = t == 0 ? kk0[jj] : kk1[jj], qv = t == 0 ? qk0[jj] : qk1[jj];
                      AM[l * 65 + s] = s < l ? sBeta[l] * sRk[l] * rks * kv * e : 0.f;
                      *(LAS unsigned short*)(QKM + l * P4 + s * 2) = (unsigned short)f2bf(sRq[l] * rks * qv * e); } } }
            for (int o = tid; o < 64 * 65; o += 512) TM[o] = 0.f;
            __syncthreads();
            if (w == 0) { float t[16]; const LAS float* Ab = AM + (16 * fq) * 65 + 16 * fq;
#pragma unroll
                for (int r = 0; r < 16; ++r) { float acc = (r == fr) ? 1.f : 0.f;
#pragma unroll
                    for (int s = 0; s < r; ++s) acc -= Ab[r * 65 + s] * t[s];
                    t[r] = acc; asm volatile("" ::: "memory"); }
#pragma unroll
                for (int r = 0; r < 16; ++r) TM[(16 * fq + r) * 65 + 16 * fq + fr] = t[r]; }
            __syncthreads();
            if (w < 2) { const int o32 = 32 * w; LAS float* X = XM + w * 272;
                f32x4 x = mm16_f32((f32x4){0.f, 0.f, 0.f, 0.f}, AM + (o32 + 16) * 65 + o32, 65, TM + o32 * 65 + o32, 65, 16, fr, fq);
#pragma unroll
                for (int jj = 0; jj < 4; ++jj) X[(fq * 4 + jj) * 17 + fr] = x[jj];
                LDS_WAIT(); asm volatile("" ::: "memory");
                f32x4 y = mm16_f32((f32x4){0.f, 0.f, 0.f, 0.f}, TM + (o32 + 16) * 65 + o32 + 16, 65, X, 17, 16, fr, fq);
#pragma unroll
                for (int jj = 0; jj < 4; ++jj) TM[(o32 + 16 + fq * 4 + jj) * 65 + o32 + fr] = -y[jj]; }
            __syncthreads();
            if (w < 4) { const int ti = w >> 1, tj = w & 1;
                f32x4 x = mm16_f32((f32x4){0.f, 0.f, 0.f, 0.f}, AM + (32 + 16 * ti) * 65, 65, TM + 16 * tj, 65, 32, fr, fq);
#pragma unroll
                for (int jj = 0; jj < 4; ++jj) XM[(16 * ti + fq * 4 + jj) * 33 + 16 * tj + fr] = x[jj]; }
            __syncthreads();
            if (w < 4) { const int ti = w >> 1, tj = w & 1;
                f32x4 y = mm16_f32((f32x4){0.f, 0.f, 0.f, 0.f}, TM + (32 + 16 * ti) * 65 + 32, 65, XM + 16 * tj, 33, 32, fr, fq);
#pragma unroll
                for (int jj = 0; jj < 4; ++jj) TM[(32 + 16 * ti + fq * 4 + jj) * 65 + 16 * tj + fr] = -y[jj]; }
            __syncthreads();
            { const int s = tid & 63; const float cs = sBeta[s] * sRk[s] * expf(sGC[s]);
#pragma unroll
              for (int i = 0; i < 8; ++i) { const int l = (tid >> 6) + 8 * i; const float tv = s <= l ? TM[l * 65 + s] : 0.f;
                  *(LAS unsigned short*)(TBb + l * P4 + s * 2) = (unsigned short)f2bf(tv); *(LAS unsigned short*)(T2b + l * P4 + s * 2) = (unsigned short)f2bf(tv * cs); } }
            __syncthreads();
            const int lt = w >> 1, et0 = 2 * (w & 1);
            f32x4 u0 = (f32x4){0.f, 0.f, 0.f, 0.f}, u1 = u0;
            { f32x4 wa[4];
#pragma unroll
              for (int q = 0; q < 4; ++q) wa[q] = (f32x4){0.f, 0.f, 0.f, 0.f};
              const int dt0 = 4 * (w & 1);
#pragma unroll
              for (int ks = 0; ks < 2; ++ks) { const bf16x8 a = ldsfrag(TBb, lt * 16 + fr, P4, ks * 64 + fq * 16), a2 = ldsfrag(T2b, lt * 16 + fr, P4, ks * 64 + fq * 16);
                  const bf16x8 b0 = ldsfrag(VBT, et0 * 16 + fr, P4, ks * 64 + fq * 16), b1 = ldsfrag(VBT, (et0 + 1) * 16 + fr, P4, ks * 64 + fq * 16);
                  u0 = __builtin_amdgcn_mfma_f32_16x16x32_bf16(a, b0, u0, 0, 0, 0); u1 = __builtin_amdgcn_mfma_f32_16x16x32_bf16(a, b1, u1, 0, 0, 0);
#pragma unroll
                  for (int q = 0; q < 4; ++q) { const bf16x8 bk = ldsfrag(KUT, (dt0 + q) * 16 + fr, P4, ks * 64 + fq * 16); wa[q] = __builtin_amdgcn_mfma_f32_16x16x32_bf16(a2, bk, wa[q], 0, 0, 0); } }
#pragma unroll
              for (int q = 0; q < 4; ++q)
#pragma unroll
                  for (int jj = 0; jj < 4; ++jj) *(LAS unsigned short*)(KU + (lt * 16 + fq * 4 + jj) * P8 + ((dt0 + q) * 16 + fr) * 2) = (unsigned short)f2bf(wa[q][jj]); }
            __syncthreads();
            f32x4 qs0 = (f32x4){0.f, 0.f, 0.f, 0.f}, qs1 = qs0;
            const float glast = sGC[63];
            { f32x4 p0 = (f32x4){0.f, 0.f, 0.f, 0.f}, p1 = p0;
#pragma unroll
              for (int ks = 0; ks < 4; ++ks) { const bf16x8 aW = ldsfrag(KU, lt * 16 + fr, P8, ks * 64 + fq * 16), aQ = ldsfrag(QU, lt * 16 + fr, P8, ks * 64 + fq * 16);
                  const bf16x8 b0 = ldsfrag(ST, et0 * 16 + fr, P8, ks * 64 + fq * 16), b1 = ldsfrag(ST, (et0 + 1) * 16 + fr, P8, ks * 64 + fq * 16);
                  p0 = __builtin_amdgcn_mfma_f32_16x16x32_bf16(aW, b0, p0, 0, 0, 0); p1 = __builtin_amdgcn_mfma_f32_16x16x32_bf16(aW, b1, p1, 0, 0, 0);
                  qs0 = __builtin_amdgcn_mfma_f32_16x16x32_bf16(aQ, b0, qs0, 0, 0, 0); qs1 = __builtin_amdgcn_mfma_f32_16x16x32_bf16(aQ, b1, qs1, 0, 0, 0); }
              const f32x4 vn0 = u0 - p0, vn1 = u1 - p1; const int l0 = lt * 16 + fq * 4;
              float c2[4];
#pragma unroll
              for (int jj = 0; jj < 4; ++jj) c2[jj] = sRk[l0 + jj] * expf(glast - sGC[l0 + jj]);
              v2u pk; pk.x = pk2(vn0[0], vn0[1]); pk.y = pk2(vn0[2], vn0[3]); *(LAS v2u*)(VBT + (et0 * 16 + fr) * P4 + l0 * 2) = pk;
              pk.x = pk2(vn1[0], vn1[1]); pk.y = pk2(vn1[2], vn1[3]); *(LAS v2u*)(VBT + ((et0 + 1) * 16 + fr) * P4 + l0 * 2) = pk;
              pk.x = pk2(vn0[0] * c2[0], vn0[1] * c2[1]); pk.y = pk2(vn0[2] * c2[2], vn0[3] * c2[3]); *(LAS v2u*)(VN2 + (et0 * 16 + fr) * P4 + l0 * 2) = pk;
              pk.x = pk2(vn1[0] * c2[0], vn1[1] * c2[1]); pk.y = pk2(vn1[2] * c2[2], vn1[3] * c2[3]); *(LAS v2u*)(VN2 + ((et0 + 1) * 16 + fr) * P4 + l0 * 2) = pk; }
            __syncthreads();
            {
#pragma unroll
              for (int jj = 0; jj < 4; ++jj) { const int l = lt * 16 + fq * 4 + jj; const float f = sRq[l] * expf(sGC[l]); qs0[jj] *= f; qs1[jj] *= f; }
#pragma unroll
              for (int ks = 0; ks < 2; ++ks) { const bf16x8 a = ldsfrag(QKM, lt * 16 + fr, P4, ks * 64 + fq * 16), b0 = ldsfrag(VBT, et0 * 16 + fr, P4, ks * 64 + fq * 16), b1 = ldsfrag(VBT, (et0 + 1) * 16 + fr, P4, ks * 64 + fq * 16);
                  qs0 = __builtin_amdgcn_mfma_f32_16x16x32_bf16(a, b0, qs0, 0, 0, 0); qs1 = __builtin_amdgcn_mfma_f32_16x16x32_bf16(a, b1, qs1, 0, 0, 0); }
#pragma unroll
              for (int jj = 0; jj < 4; ++jj) { float* op = O + (row0 + lt * 16 + fq * 4 + jj) * GD_VTOT + hv * 128 + half * 64 + et0 * 16 + fr; op[0] = qs0[jj]; op[16] = qs1[jj]; }
              const float dl = expf(glast);
#pragma unroll
              for (int e = 0; e < 4; ++e) Sacc[e] = Sacc[e] * dl;
#pragma unroll
              for (int ks = 0; ks < 2; ++ks) { const bf16x8 a = ldsfrag(KUT, w * 16 + fr, P4, ks * 64 + fq * 16);
#pragma unroll
                  for (int e = 0; e < 4; ++e) { const bf16x8 bb = ldsfrag(VN2, e * 16 + fr, P4, ks * 64 + fq * 16); Sacc[e] = __builtin_amdgcn_mfma_f32_16x16x32_bf16(a, bb, Sacc[e], 0, 0, 0); } }
#pragma unroll
              for (int e = 0; e < 4; ++e) { v2u pk; pk.x = pk2(Sacc[e][0], Sacc[e][1]); pk.y = pk2(Sacc[e][2], Sacc[e][3]); *(LAS v2u*)(ST + (e * 16 + fr) * P8 + (w * 16 + fq * 4) * 2) = pk; } }
            __syncthreads();
        }
#undef GD_PREFETCH
    }
}

__device__ __forceinline__ void gdn_gate_phase(Frame& F, int j) {
    const int gw = blockIdx.x * NWAVES + F.wave, NGW = F.G * NWAVES;
    const float* S = (const float*)(F.ws + WS_SCAN); const bf16* P = (const bf16*)(F.ws + WS_PROJ); bf16* Yo = (bf16*)(F.ws + WS_YMIX);
    const f32x2 g = *((const GAS f32x2*)(inp(F, I_GD_NG) + (size_t)j * 128) + F.lane);
    for (int m = gw; m < M; m += NGW) {
#pragma unroll 4
        for (int hv = 0; hv < GD_HV; ++hv) {
            const f32x2 a = *((const GAS f32x2*)(S + (size_t)m * GD_VTOT + hv * 128) + F.lane);
            const float ss = wave_sum(a.x * a.x + a.y * a.y); const float rstd = 1.0f / sqrtf(ss * (1.0f / 128.0f) + EPS);
            const unsigned z = *((const GAS unsigned*)(P + (size_t)m * GD_N + GD_CONVCH + hv * 128) + F.lane);
            const float z0 = bflo(z), z1 = bfhi(z);
            *((GAS unsigned*)(Yo + (size_t)m * GD_VTOT + hv * 128) + F.lane) = pk2(a.x * rstd * g.x * z0 * sigmoid_f(z0), a.y * rstd * g.y * z1 * sigmoid_f(z1));
        }
    }
}

struct Args { const float* in[15]; float* out; unsigned char* ws; };
__global__ void __launch_bounds__(NWAVES * 64, 2) mk_fwd(Args args) {
    extern __shared__ __attribute__((aligned(16))) unsigned char lds[];
    Frame F;
    F.lds = (LAS unsigned char*)lds;
    F.MISC = (volatile LAS unsigned*)(F.lds + MISC_OFF);
    F.tid = threadIdx.x; F.lane = F.tid & 63; F.wave = __builtin_amdgcn_readfirstlane(F.tid >> 6);
    F.G = gridDim.x;
    F.ws = args.ws; F.ctl = (gu32*)(args.ws + WS_CTL);
    F.out = args.out;
    for (int u = F.tid; u < (PTR_OFF - LDSCTL_OFF) / 4; u += NWAVES * 64) ((LAS unsigned*)(F.lds + LDSCTL_OFF))[u] = 0u;
    if (F.tid == 0) {
#pragma unroll
        for (int i = 0; i < 15; ++i) ((LAS unsigned long long*)(F.lds + PTR_OFF))[i] = (unsigned long long)args.in[i];
    }
    __syncthreads();
    XcdBarrier bar = xcd_barrier_post((unsigned*)(F.ctl + CW_BAR), F.MISC + 8);
#define GRID_BAR() xcd_barrier(bar)

    prologue(F); GRID_BAR();

    const pg8::bf16_t* HN = (const pg8::bf16_t*)(F.ws + WS_HN);
    for (int L = 0; L < DEPTH; ++L) {
        for (int s = 0; s < 2; ++s) {
            relaunder(F);
            { pg8::Gemm g{HN, (const pg8::bf16_t*)(F.ws + WS_W1 + (size_t)(2 * L + s) * SZ_W1), M, NFF1, D}; pg8::StaticOrder S; S.init(M, NFF1, F.G, (int)blockIdx.x);
              pg8::EpiSwiGLU E{(pg8::bf16_t*)(F.ws + WS_ACT), DFF};
              pg8::gemm_phase<pg8::EpiSwiGLU, pg8::StaticOrder, true, true>(F.lds + RING_OFF, g, S, E); }
            GRID_BAR();
            { pg8::Gemm g{(const pg8::bf16_t*)(F.ws + WS_ACT), (const pg8::bf16_t*)(F.ws + WS_W2 + (size_t)(2 * L + s) * SZ_W2), M, D, DFF}; pg8::StaticOrder S; S.init(M, D, F.G, (int)blockIdx.x);
              pg8::EpiF32 E{(float*)(F.ws + WS_Y), D};
              pg8::gemm_phase<pg8::EpiF32, pg8::StaticOrder, true, true>(F.lds + RING_OFF, g, S, E); }
            GRID_BAR();
            if (s == 0) norm_phase(F, 0.5f, inp(F, I_NORMG) + (size_t)L * 6 * D + 1 * D, inp(F, I_NORMG) + (size_t)L * 6 * D + 2 * D, true);
            else        norm_phase(F, 0.5f, inp(F, I_NORMG) + (size_t)L * 6 * D + 5 * D, inp(F, I_NORMG) + (size_t)L * 6 * D + 6 * D, L + 1 < DEPTH);
            GRID_BAR();
            if (s == 0) {
                const int j = L >> 1;
                relaunder(F);
                if ((L & 1) == 0) {
                    skinny_phase<1>(F, (const bf16*)(F.ws + WS_MLX + (size_t)j * SZ_MLX), (float*)(F.ws + WS_GATES));
                    { pg8::Gemm g{HN, (const pg8::bf16_t*)(F.ws + WS_MLIN + (size_t)j * SZ_MLIN), M, ML_N, D}; pg8::StaticOrder S; S.init(M, ML_N, F.G, (int)blockIdx.x);
                      pg8::EpiBf16 E{(pg8::bf16_t*)(F.ws + WS_PROJ), ML_N};
                      pg8::gemm_phase<pg8::EpiBf16, pg8::StaticOrder, true, true>(F.lds + RING_OFF, g, S, E); }
                    GRID_BAR();
                    ml_scan_fast(F, j);
                    GRID_BAR();
                    ml_gate_phase(F, j);
                    GRID_BAR();
                    { pg8::Gemm g{(const pg8::bf16_t*)(F.ws + WS_YMIX), (const pg8::bf16_t*)(F.ws + WS_MLOUT + (size_t)j * SZ_MLOUT), M, D, ML_V}; pg8::StaticOrder S; S.init(M, D, F.G, (int)blockIdx.x);
                      pg8::EpiF32 E{(float*)(F.ws + WS_Y), D};
                      pg8::gemm_phase<pg8::EpiF32, pg8::StaticOrder, true, true>(F.lds + RING_OFF, g, S, E); }
                    GRID_BAR();
                } else {
                    skinny_phase<4>(F, (const bf16*)(F.ws + WS_GDX + (size_t)j * SZ_GDX), (float*)(F.ws + WS_GATES));
                    { pg8::Gemm g{HN, (const pg8::bf16_t*)(F.ws + WS_GDIN + (size_t)j * SZ_GDIN), M, GD_N, D}; pg8::StaticOrder S; S.init(M, GD_N, F.G, (int)blockIdx.x);
                      pg8::EpiBf16 E{(pg8::bf16_t*)(F.ws + WS_PROJ), GD_N};
                      pg8::gemm_phase<pg8::EpiBf16, pg8::StaticOrder, true, true>(F.lds + RING_OFF, g, S, E); }
                    GRID_BAR();
                    gdn_scan_fast(F, j);
                    GRID_BAR();
                    gdn_gate_phase(F, j);
                    GRID_BAR();
                    { pg8::Gemm g{(const pg8::bf16_t*)(F.ws + WS_YMIX), (const pg8::bf16_t*)(F.ws + WS_GDOUT + (size_t)j * SZ_GDOUT), M, D, GD_VTOT}; pg8::StaticOrder S; S.init(M, D, F.G, (int)blockIdx.x);
                      pg8::EpiF32 E{(float*)(F.ws + WS_Y), D};
                      pg8::gemm_phase<pg8::EpiF32, pg8::StaticOrder, true, true>(F.lds + RING_OFF, g, S, E); }
                    GRID_BAR();
                }
                norm_phase(F, 1.0f, inp(F, I_NORMG) + (size_t)L * 6 * D + 3 * D, inp(F, I_NORMG) + (size_t)L * 6 * D + 4 * D, true);
                GRID_BAR();
            }
        }
    }
}

extern "C" void kernel_launch(void* const* d_in, const int* in_sizes, int n_in, void* d_out, int out_size, void* d_ws, size_t ws_size, hipStream_t stream) {
    static int grid = 0;
    if (grid == 0) {
        if (n_in != 15 || in_sizes[0] != M * D || out_size != M * D || ws_size < WS_END) { fprintf(stderr, "kernel_launch: unexpected shapes (n_in %d, in0 %d, out %d, ws %zu < %zu); nothing launched\n", n_in, n_in > 0 ? in_sizes[0] : -1, out_size, ws_size, (size_t)WS_END); grid = -1; return; }
        int dev = 0, cus = 0, per_cu = 0;
        if (hipGetDevice(&dev) != hipSuccess || hipDeviceGetAttribute(&cus, hipDeviceAttributeMultiprocessorCount, dev) != hipSuccess) { grid = -1; return; }
        if (hipFuncSetAttribute((const void*)mk_fwd, hipFuncAttributeMaxDynamicSharedMemorySize, LDS_BYTES) != hipSuccess) { fprintf(stderr, "kernel_launch: hipFuncSetAttribute failed\n"); grid = -1; return; }
        if (hipOccupancyMaxActiveBlocksPerMultiprocessor(&per_cu, (const void*)mk_fwd, NWAVES * 64, LDS_BYTES) != hipSuccess || per_cu < 1) { fprintf(stderr, "kernel_launch: occupancy query says %d\n", per_cu); (void)hipGetLastError(); grid = -1; return; }
        (void)hipGetLastError();
        grid = cus;
    }
    if (grid < 0) return;
    if (hipMemsetAsync((char*)d_ws + WS_CTL, 0, CTL_ZERO_BYTES, stream) != hipSuccess) return;
    Args a{};
    for (int i = 0; i < 15; ++i) a.in[i] = (const float*)d_in[i];
    a.out = (float*)d_out; a.ws = (unsigned char*)d_ws;
    hipLaunchKernelGGL(mk_fwd, dim3(grid), dim3(NWAVES * 64), LDS_BYTES, stream, a);
}
```

```cpp
#include <hip/hip_runtime.h>
#include <cstdio>
#include <cstdint>
namespace pg8 {
#define PG8_LAS __attribute__((address_space(3)))
typedef unsigned short bf16_t;
typedef short bf16x8 __attribute__((ext_vector_type(8)));
typedef float f32x4 __attribute__((ext_vector_type(4)));
typedef unsigned u32x4 __attribute__((ext_vector_type(4)));
constexpr int BM = 256, BK = 64, HALF = 128, HTB = HALF * BK * 2  , STAGE_BYTES = 8 * HTB, NXCD = 8, WGM = 8;

__host__ __device__ __forceinline__ int lds_byte(int r, int c) { const int st = (r >> 4) * 2 + (c >> 5), rr = r & 15, cc = c & 31, ob = rr * 64 + cc * 2; return st * 1024 + (ob ^ (((ob >> 9) & 1) << 5)); }
__host__ __device__ __forceinline__ void stage_rc(int b, int& R, int& C) { const int st = b / 1024, sb = b % 1024, swz = sb ^ (((sb >> 9) & 1) << 5); R = (st >> 1) * 16 + swz / 64; C = (st & 1) * 32 + (swz % 64) / 2; }
__host__ __device__ __forceinline__ int perm32(int rho) { const int n = rho >> 4, i = rho & 15; return 8 * (i >> 2) + 4 * n + (i & 3); }

struct Unit { int pm, pn; };
struct Gemm { const bf16_t* A; const bf16_t* Bt; int M, N, K; };

struct StaticOrder {
    int nM, nN, nwg, G, c;
    __host__ __device__ void init(int M, int N, int G_, int c_) { nM = M / BM; nN = N / BM; nwg = nM * nN; G = G_; c = c_; }
    __host__ __device__ bool next(int i, Unit& u) const {
        const long L = (long)i * G + c; if (L >= nwg) return false;
        int wgid = (int)L; { const int q = nwg / NXCD, r = nwg % NXCD, xcd = wgid % NXCD, off = wgid / NXCD; wgid = (xcd < r ? xcd * (q + 1) : r * (q + 1) + (xcd - r) * q) + off; }
        const int nig = WGM * nN, gid = wgid / nig, fm = gid * WGM, gsz = (nM - fm) < WGM ? (nM - fm) : WGM;
        u.pm = fm + ((wgid % nig) % gsz); u.pn = (wgid % nig) / gsz; return true;
    }
    __device__ __forceinline__ void a_ready(const Unit&) const {}
    __device__ __forceinline__ void done(const Unit&) const {}
};

__device__ __forceinline__ unsigned cvt_pk_bf16(float lo, float hi) { unsigned r; asm volatile("v_cvt_pk_bf16_f32 %0, %1, %2" : "=v"(r) : "v"(lo), "v"(hi)); return r; }
typedef float f32x2 __attribute__((ext_vector_type(2)));
struct EpiF32 {
    static constexpr bool PERM = false, AFTER_DRAIN = false;
    float* C; int ldc;
    __device__ __forceinline__ void operator()(const f32x4 (&acc)[2][2][4][2], const Unit& u, int wr, int wc, int fr, int fq) const {
        const int row0 = u.pm * BM + wr * 64 + fr, col0 = u.pn * BM + wc * 32 + 4 * fq;
#pragma unroll
        for (int ai = 0; ai < 2; ++ai)
#pragma unroll
            for (int m = 0; m < 4; ++m) { float* rowp = C + (size_t)(row0 + ai * HALF + m * 16) * ldc + col0;
#pragma unroll
                for (int bj = 0; bj < 2; ++bj)
#pragma unroll
                    for (int n = 0; n < 2; ++n) *(f32x4*)(rowp + bj * HALF + n * 16) = acc[ai][bj][m][n]; }
    }
};
struct EpiBf16 {
    static constexpr bool PERM = true, AFTER_DRAIN = false;
    bf16_t* O; int ldc;
    __device__ __forceinline__ void operator()(const f32x4 (&acc)[2][2][4][2], const Unit& u, int wr, int wc, int fr, int fq) const {
        const int row0 = u.pm * BM + wr * 64 + fr; const int col0 = u.pn * BM + wc * 32 + 8 * fq;
#pragma unroll
        for (int ai = 0; ai < 2; ++ai)
#pragma unroll
            for (int m = 0; m < 4; ++m) { bf16_t* rowp = O + (size_t)(row0 + ai * HALF + m * 16) * ldc + col0;
#pragma unroll
                for (int bj = 0; bj < 2; ++bj) { const f32x4 v0 = acc[ai][bj][m][0], v1 = acc[ai][bj][m][1];
                    u32x4 w; w.x = cvt_pk_bf16(v0[0], v0[1]); w.y = cvt_pk_bf16(v0[2], v0[3]); w.z = cvt_pk_bf16(v1[0], v1[1]); w.w = cvt_pk_bf16(v1[2], v1[3]);
                    *(u32x4*)(rowp + bj * HALF) = w; } }
    }
};
__device__ __forceinline__ float silu_f(float g) { return g * __builtin_amdgcn_rcpf(1.0f + __builtin_amdgcn_exp2f(-1.4426950408889634f * g)); }
struct EpiSwiGLU {
    static constexpr bool PERM = true, AFTER_DRAIN = false;
    bf16_t* O; int ldc;
    __device__ __forceinline__ void operator()(const f32x4 (&acc)[2][2][4][2], const Unit& u, int wr, int wc, int fr, int fq) const {
        const int row0 = u.pm * BM + wr * 64 + fr; const int col0 = u.pn * HALF + wc * 32 + 8 * fq;
#pragma unroll
        for (int ai = 0; ai < 2; ++ai)
#pragma unroll
            for (int m = 0; m < 4; ++m) { bf16_t* rowp = O + (size_t)(row0 + ai * HALF + m * 16) * ldc + col0;
                const f32x4 g0 = acc[ai][0][m][0], g1 = acc[ai][0][m][1], u0 = acc[ai][1][m][0], u1 = acc[ai][1][m][1];
                u32x4 w; w.x = cvt_pk_bf16(silu_f(g0[0]) * u0[0], silu_f(g0[1]) * u0[1]); w.y = cvt_pk_bf16(silu_f(g0[2]) * u0[2], silu_f(g0[3]) * u0[3]);
                w.z = cvt_pk_bf16(silu_f(g1[0]) * u1[0], silu_f(g1[1]) * u1[1]); w.w = cvt_pk_bf16(silu_f(g1[2]) * u1[2], silu_f(g1[3]) * u1[3]);
                *(u32x4*)rowp = w; }
    }
};

template <class Epi, class Sched, bool ALIGN_EPI = false, bool SP2 = false>
__device__ __forceinline__ void gemm_phase(PG8_LAS unsigned char* lds, const Gemm g, const Sched& S, const Epi& E) {
    int tid_ = threadIdx.x; asm volatile("" : "+v"(tid_)); const int tid = tid_, wid = __builtin_amdgcn_readfirstlane(tid >> 6), lane = tid & 63, wr = wid >> 2, wc = wid & 3, fr = lane & 15, fq = lane >> 4;
    const int K = g.K, nt = K / BK;
    unsigned voffA[2], voffB[2];
#pragma unroll
    for (int i = 0; i < 2; ++i) { int R, C; stage_rc(tid * 16 + i * 8192, R, C); const int Rb = Epi::PERM ? ((R & ~31) + perm32(R & 31)) : R;
        voffA[i] = (unsigned)(R * K + C) * 2u; voffB[i] = (unsigned)(Rb * K + C) * 2u; }
    const size_t kstep = (size_t)(BK * 2);
    const size_t hstep = (size_t)HALF * K * 2;
    const size_t tstep = 2 * hstep;
    const unsigned ldsw = (unsigned)wid * 1024u;
    const int aoff = lds_byte(wr * 64 + fr, fq * 8), boff = lds_byte(wc * 32 + fr, fq * 8);
#define PG8_SA(b, h) (((b) * 2 + (h)) * HTB)
#define PG8_SB(b, h) ((4 + (b) * 2 + (h)) * HTB)
#define PG8_STAGE(bufoff, gbase, voff) do { _Pragma("unroll") for (int _i = 0; _i < 2; ++_i) \
        __builtin_amdgcn_global_load_lds((const unsigned*)((const char*)(gbase) + (voff)[_i]), (PG8_LAS unsigned*)(lds + (bufoff) + ldsw + _i * 8192), 16, 0, 0); } while (0)
#define PG8_LDA(dst, b, h) do { _Pragma("unroll") for (int m = 0; m < 4; ++m) _Pragma("unroll") for (int k = 0; k < 2; ++k) dst[m][k] = *(const PG8_LAS bf16x8*)(lds + PG8_SA(b, h) + aoff + m * 2048 + k * 1024); } while (0)
#define PG8_LDB(dst, b, h) do { _Pragma("unroll") for (int n = 0; n < 2; ++n) _Pragma("unroll") for (int k = 0; k < 2; ++k) dst[n][k] = *(const PG8_LAS bf16x8*)(lds + PG8_SB(b, h) + boff + n * 2048 + k * 1024); } while (0)
#define PG8_MMA(ai, bj, At, Bt) do { __builtin_amdgcn_s_setprio(1); _Pragma("unroll") for (int m = 0; m < 4; ++m) _Pragma("unroll") for (int n = 0; n < 2; ++n) _Pragma("unroll") for (int k = 0; k < 2; ++k) \
        acc[ai][bj][m][n] = __builtin_amdgcn_mfma_f32_16x16x32_bf16(Bt[n][k], At[m][k], acc[ai][bj][m][n], 0, 0, 0); __builtin_amdgcn_s_setprio(0); } while (0)
#define PG8_WAIT_V(n) asm volatile("s_waitcnt vmcnt(" #n ")" ::: "memory")
#define PG8_WAIT_L(n) asm volatile("s_waitcnt lgkmcnt(" #n ")" ::: "memory")
#define PG8_BAR __builtin_amdgcn_s_barrier()
#define PG8_SCHED __builtin_amdgcn_sched_barrier(0)
    Unit cur, nxt; int ui = 0;
    if (!S.next(0, cur)) return;
    f32x4 acc[2][2][4][2];
#pragma unroll
    for (int a = 0; a < 2; ++a)
#pragma unroll
        for (int b = 0; b < 2; ++b)
#pragma unroll
            for (int m = 0; m < 4; ++m)
#pragma unroll
                for (int n = 0; n < 2; ++n) acc[a][b][m][n] = (f32x4){0.f, 0.f, 0.f, 0.f};
    bf16x8 At[4][2], B0[2][2], B1[2][2];
    const char* cA = (const char*)g.A + (size_t)cur.pm * tstep; const char* cB = (const char*)g.Bt + (size_t)cur.pn * tstep;
    S.a_ready(cur);
    if constexpr (SP2) {
        PG8_STAGE(PG8_SB(0, 0), cB, voffB); PG8_STAGE(PG8_SB(0, 1), cB + hstep, voffB); PG8_STAGE(PG8_SA(0, 0), cA, voffA); PG8_STAGE(PG8_SA(0, 1), cA + hstep, voffA);
        if (wr == 1) PG8_BAR;
        PG8_WAIT_V(2); PG8_BAR;
        PG8_STAGE(PG8_SB(1, 0), cB + kstep, voffB); PG8_STAGE(PG8_SA(1, 0), cA + kstep, voffA); PG8_STAGE(PG8_SB(1, 1), cB + hstep + kstep, voffB);
        PG8_WAIT_V(6); PG8_BAR;
    } else {
        PG8_STAGE(PG8_SB(0, 0), cB, voffB); PG8_STAGE(PG8_SA(0, 0), cA, voffA); PG8_STAGE(PG8_SB(0, 1), cB + hstep, voffB); PG8_STAGE(PG8_SA(0, 1), cA + hstep, voffA);
        if (wr == 1) PG8_BAR;
        PG8_WAIT_V(4); PG8_BAR;
        PG8_STAGE(PG8_SB(1, 0), cB + kstep, voffB); PG8_STAGE(PG8_SA(1, 0), cA + kstep, voffA); PG8_STAGE(PG8_SB(1, 1), cB + hstep + kstep, voffB);
        PG8_WAIT_V(6); PG8_BAR;
    }
    for (;;) {
        const bool has_next = S.next(ui + 1, nxt);
        const char* nA = has_next ? (const char*)g.A + (size_t)nxt.pm * tstep : cA; const char* nB = has_next ? (const char*)g.Bt + (size_t)nxt.pn * tstep : cB;
        for (int t = 0; t < nt; t += 2) {
            const bool last = (t == nt - 2);
            const char* a1 = cA + (size_t)(t + 1) * kstep;
            const char* a2 = last ? nA : cA + (size_t)(t + 2) * kstep; const char* b2 = last ? nB : cB + (size_t)(t + 2) * kstep;
            const char* a3 = a2 + kstep; const char* b3 = b2 + kstep;
            if (last && has_next) S.a_ready(nxt);
            if constexpr (SP2) {
            PG8_LDB(B0, 0, 0); PG8_LDB(B1, 0, 1); PG8_SCHED; PG8_LDA(At, 0, 0); PG8_STAGE(PG8_SA(1, 1), a1 + hstep, voffA);
            PG8_WAIT_V(8); PG8_WAIT_L(0); PG8_BAR; PG8_MMA(0, 0, At, B0); PG8_MMA(0, 1, At, B1); PG8_BAR; PG8_SCHED;
            PG8_LDA(At, 0, 1); PG8_STAGE(PG8_SB(0, 0), b2, voffB); PG8_STAGE(PG8_SB(0, 1), b2 + hstep, voffB); PG8_STAGE(PG8_SA(0, 0), a2, voffA);
            PG8_WAIT_V(8); PG8_WAIT_L(0); PG8_BAR; PG8_MMA(1, 0, At, B0); PG8_MMA(1, 1, At, B1); PG8_BAR; PG8_SCHED;
            PG8_LDB(B0, 1, 0); PG8_LDB(B1, 1, 1); PG8_SCHED; PG8_LDA(At, 1, 0); PG8_STAGE(PG8_SA(0, 1), a2 + hstep, voffA);
            PG8_WAIT_V(8); PG8_WAIT_L(0); PG8_BAR; PG8_MMA(0, 0, At, B0); PG8_MMA(0, 1, At, B1); PG8_BAR; PG8_SCHED;
            PG8_LDA(At, 1, 1); PG8_STAGE(PG8_SB(1, 0), b3, voffB); PG8_STAGE(PG8_SB(1, 1), b3 + hstep, voffB); PG8_STAGE(PG8_SA(1, 0), a3, voffA);
            PG8_WAIT_V(8); PG8_WAIT_L(0); PG8_BAR; PG8_MMA(1, 0, At, B0); PG8_MMA(1, 1, At, B1); PG8_BAR; PG8_SCHED;
            } else {
            PG8_LDB(B0, 0, 0); PG8_SCHED; PG8_LDA(At, 0, 0); PG8_STAGE(PG8_SA(1, 1), a1 + hstep, voffA);
            PG8_WAIT_L(8); PG8_BAR; PG8_WAIT_L(0); PG8_MMA(0, 0, At, B0); PG8_BAR; PG8_SCHED;
            PG8_LDB(B1, 0, 1); PG8_STAGE(PG8_SB(0, 0), b2, voffB);
            PG8_BAR; PG8_WAIT_L(0); PG8_MMA(0, 1, At, B1); PG8_BAR;
            PG8_LDA(At, 0, 1); PG8_STAGE(PG8_SA(0, 0), a2, voffA);
            PG8_BAR; PG8_WAIT_L(0); PG8_MMA(1, 0, At, B0); PG8_BAR; PG8_SCHED;
            PG8_STAGE(PG8_SB(0, 1), b2 + hstep, voffB);
            PG8_WAIT_V(6); PG8_BAR; PG8_MMA(1, 1, At, B1); PG8_BAR;
            PG8_LDB(B0, 1, 0); PG8_SCHED; PG8_LDA(At, 1, 0); PG8_STAGE(PG8_SA(0, 1), a2 + hstep, voffA);
            PG8_WAIT_L(8); PG8_BAR; PG8_WAIT_L(0); PG8_MMA(0, 0, At, B0); PG8_BAR; PG8_SCHED;
            PG8_LDB(B1, 1, 1); PG8_STAGE(PG8_SB(1, 0), b3, voffB);
            PG8_BAR; PG8_WAIT_L(0); PG8_MMA(0, 1, At, B1); PG8_BAR;
            PG8_LDA(At, 1, 1); PG8_STAGE(PG8_SA(1, 0), a3, voffA);
            PG8_BAR; PG8_WAIT_L(0); PG8_MMA(1, 0, At, B0); PG8_BAR; PG8_SCHED;
            PG8_STAGE(PG8_SB(1, 1), b3 + hstep, voffB);
            PG8_WAIT_V(6); PG8_BAR; PG8_MMA(1, 1, At, B1); PG8_BAR;
            }
        }
        if constexpr (ALIGN_EPI) { if (wr == 0) PG8_BAR; }
        if constexpr (!Epi::AFTER_DRAIN) { E(acc, cur, wr, wc, fr, fq); S.done(cur); }
        if (!has_next) break;
#pragma unroll
        for (int a = 0; a < 2; ++a)
#pragma unroll
            for (int b = 0; b < 2; ++b)
#pragma unroll
                for (int m = 0; m < 4; ++m)
#pragma unroll
                    for (int n = 0; n < 2; ++n) acc[a][b][m][n] = (f32x4){0.f, 0.f, 0.f, 0.f};
        cur = nxt; cA = nA; cB = nB; ++ui;
        if constexpr (ALIGN_EPI) { if (wr == 1) PG8_BAR; }
    }
    PG8_WAIT_V(0);
    if constexpr (!ALIGN_EPI) { if (wr == 0) PG8_BAR; }
    PG8_BAR;
    if constexpr (Epi::AFTER_DRAIN) { E.fused(acc, cur, wr, wc, fr, fq, lds, wid, lane); S.done(cur); }
#undef PG8_SA
#undef PG8_SB
#undef PG8_STAGE
#undef PG8_LDA
#undef PG8_LDB
#undef PG8_MMA
#undef PG8_WAIT_V
#undef PG8_WAIT_L
#undef PG8_BAR
#undef PG8_SCHED
}
}

constexpr int NWAVES = 8;
constexpr int BATCH = 4, SEQ = 2048, D = 2048, M = BATCH * SEQ, DEPTH = 4;
constexpr int DFF = 5504, NFF1 = 2 * DFF;
constexpr int ML_H = 4, ML_DQK = 256, ML_DV = 512, ML_QK = 1024, ML_V = 2048, ML_IN = 6152, ML_N = 6144;
constexpr int GD_HK = 16, GD_HV = 32, GD_CONVCH = 8192, GD_IN = 12352, GD_N = 12288, GD_VTOT = 4096;
constexpr float EPS = 1e-6f;

constexpr size_t MiB = 1u << 20;
constexpr size_t WS_CTL = 0, CTL_ZERO_BYTES = 1 * MiB;
constexpr size_t SZ_W1 = (size_t)NFF1 * D * 2, SZ_W2 = (size_t)D * DFF * 2;
constexpr size_t SZ_MLIN = (size_t)ML_N * D * 2, SZ_MLOUT = (size_t)D * ML_V * 2, SZ_GDIN = (size_t)GD_N * D * 2, SZ_GDOUT = (size_t)D * GD_VTOT * 2;
constexpr size_t SZ_MLX = (size_t)16 * D * 2, SZ_GDX = (size_t)64 * D * 2;
constexpr size_t WS_W1 = 2 * MiB;
constexpr size_t WS_W2 = WS_W1 + 8 * SZ_W1;
constexpr size_t WS_MLIN = WS_W2 + 8 * SZ_W2;
constexpr size_t WS_MLOUT = WS_MLIN + 2 * SZ_MLIN;
constexpr size_t WS_GDIN = WS_MLOUT + 2 * SZ_MLOUT;
constexpr size_t WS_GDOUT = WS_GDIN + 2 * SZ_GDIN;
constexpr size_t WS_MLX = WS_GDOUT + 2 * SZ_GDOUT;
constexpr size_t WS_GDX = WS_MLX + 2 * SZ_MLX;
constexpr size_t WS_HN = WS_GDX + 2 * SZ_GDX;
constexpr size_t WS_ACT = WS_HN + (size_t)M * D * 2;
constexpr size_t WS_Y = WS_ACT + (size_t)M * DFF * 2;
constexpr size_t WS_PROJ = WS_Y + (size_t)M * D * 4;
constexpr size_t WS_GATES = WS_PROJ + (size_t)M * GD_N * 2;
constexpr size_t WS_SCAN = WS_GATES + (size_t)M * 64 * 4;
constexpr size_t WS_YMIX = WS_SCAN + (size_t)M * 4096 * 4;
constexpr size_t WS_END = WS_YMIX + (size_t)M * 4096 * 2;
static_assert(WS_W1 % 256 == 0 && WS_W2 % 256 == 0 && WS_HN % 256 == 0 && WS_ACT % 256 == 0 && WS_Y % 256 == 0 && WS_PROJ % 256 == 0 && WS_SCAN % 256 == 0 && WS_YMIX % 256 == 0, "alignment");
constexpr int CW_TMO = 0, CW_CODE = 1;
constexpr int CW_BAR = 4096;

constexpr int RING_OFF = 0, RING_BYTES = 131072;
constexpr int LDSCTL_OFF = RING_BYTES, MISC_OFF = LDSCTL_OFF + 320;
constexpr int LDS_BYTES = 147456;
static_assert(MISC_OFF + 128 <= LDS_BYTES, "LDS map");

#define GAS __attribute__((address_space(1)))
#define LAS __attribute__((address_space(3)))
typedef unsigned short bf16;
typedef unsigned v4u __attribute__((ext_vector_type(4)));
typedef unsigned v2u __attribute__((ext_vector_type(2)));
typedef float f32x4 __attribute__((ext_vector_type(4)));
typedef float f32x2 __attribute__((ext_vector_type(2)));
typedef short bf16x8 __attribute__((ext_vector_type(8)));
typedef GAS unsigned gu32;
#define RLX_AGENT __ATOMIC_RELAXED, __HIP_MEMORY_SCOPE_AGENT
#define LDS_WAIT() asm volatile("s_waitcnt lgkmcnt(0)" ::: "memory")
#define VM_WAIT() asm volatile("s_waitcnt vmcnt(0)" ::: "memory")
__device__ __forceinline__ unsigned f2bf(float f) { unsigned u = __builtin_bit_cast(unsigned, f); return (u + 0x7fffu + ((u >> 16) & 1u)) >> 16; }
typedef __bf16 bf16x2_t __attribute__((ext_vector_type(2)));
__device__ __forceinline__ unsigned pk2(float lo, float hi) { const f32x2 v = {lo, hi}; const bf16x2_t b = __builtin_convertvector(v, bf16x2_t); return __builtin_bit_cast(unsigned, b); }
__device__ __forceinline__ unsigned short bf1(float x) { return (unsigned short)pk2(x, x); }
__device__ __forceinline__ float fexp(float x) { return __builtin_amdgcn_exp2f(x * 1.4426950408889634f); }
__device__ __forceinline__ float frcp(float x) { return __builtin_amdgcn_rcpf(x); }
__device__ __forceinline__ float fsigmoid(float x) { return frcp(1.0f + fexp(-x)); }
__device__ __forceinline__ float ftanh(float x) { return 1.0f - 2.0f * frcp(1.0f + fexp(2.0f * x)); }
__device__ __forceinline__ float flog(float x) { return __builtin_amdgcn_logf(x) * 0.6931471805599453f; }
__device__ __forceinline__ float bf2f(unsigned short b) { return __builtin_bit_cast(float, (unsigned)b << 16); }
__device__ __forceinline__ float bflo(unsigned w) { return __builtin_bit_cast(float, w << 16); }
__device__ __forceinline__ float bfhi(unsigned w) { return __builtin_bit_cast(float, w & 0xffff0000u); }

#define XB_TMO      128
#define XB_XCNT(j)  (256  + 64 * (j))
#define XB_XSUB(j)  (1280 + 64 * (j))
#define XB_XGEN(j)  (2304 + 64 * (j))
#define XB_TOP      3328
#define XB_TOPGEN   3392
#define XCD_BAR_WORDS 3456
#define XB_SPIN_CAP (1u << 18)

__device__ __forceinline__ unsigned xb_ld(unsigned* p)              { return __hip_atomic_load(p, __ATOMIC_RELAXED, __HIP_MEMORY_SCOPE_AGENT); }
__device__ __forceinline__ unsigned xb_add(unsigned* p, unsigned v) { return __hip_atomic_fetch_add(p, v, __ATOMIC_RELAXED, __HIP_MEMORY_SCOPE_AGENT); }
__device__ __forceinline__ unsigned xb_xcc_id() { return (unsigned)__builtin_amdgcn_s_getreg((3 << 11) | 20) & 0xFu; }
#define XB_SPIN(cond, bar) do { unsigned _sp = 0; while (cond) { __builtin_amdgcn_s_sleep(1); \
    if ((++_sp & 255u) == 0u) { if (xb_ld(&(bar)[XB_TMO])) break; if (_sp > XB_SPIN_CAP) { atomicAdd(&(bar)[XB_TMO], 1u); break; } } } } while (0)

struct XcdBarrier {
    unsigned* bar; unsigned x;
    volatile LAS unsigned* st;
};
__device__ __forceinline__ XcdBarrier xcd_barrier_post(unsigned* bar, volatile LAS unsigned* st) {
    XcdBarrier b; b.bar = bar; b.x = xb_xcc_id(); b.st = st;
    if (threadIdx.x == 0) (void)xb_add(&bar[XB_XCNT(b.x)], 1u);
    return b;
}
__device__ __forceinline__ void xcd_barrier_complete(unsigned* bar, unsigned x, unsigned& nloc, unsigned& nx) {
    const unsigned G = gridDim.x * gridDim.y * gridDim.z;
    unsigned sum, cnt, mine, sp = 0u;
    for (;;) {
        sum = 0u; cnt = 0u; mine = 0u;
#pragma unroll
        for (unsigned j = 0; j < 16; ++j) { const unsigned c = xb_ld(&bar[XB_XCNT(j)]); sum += c; cnt += (c > 0u) ? 1u : 0u; mine = (j == x) ? c : mine; }
        if (sum == G) break;
        __builtin_amdgcn_s_sleep(1);
        if ((++sp & 255u) == 0u) { if (xb_ld(&bar[XB_TMO])) break; if (sp > XB_SPIN_CAP) { atomicAdd(&bar[XB_TMO], 1u); break; } }
    }
    nloc = mine > 0u ? mine : 1u; nx = cnt > 0u ? cnt : 1u;
}
__device__ __forceinline__ void xcd_barrier(const XcdBarrier& b) {
    asm volatile("s_waitcnt vmcnt(0)" ::: "memory");
    __syncthreads();
    if (threadIdx.x == 0) {
        unsigned* bar = b.bar;
        __builtin_amdgcn_s_waitcnt(0);
        unsigned nloc = b.st[0], nx = b.st[1];
        if (nloc == 0u) { xcd_barrier_complete(bar, b.x, nloc, nx); b.st[0] = nloc; b.st[1] = nx; }
        const unsigned old = xb_add(&bar[XB_XSUB(b.x)], 1u);
        const unsigned gen = old / nloc;
        if (old + 1u == (gen + 1u) * nloc) {
            __builtin_amdgcn_fence(__ATOMIC_RELEASE, "agent");
            asm volatile("s_waitcnt vmcnt(0)" ::: "memory");
            const unsigned og = xb_add(&bar[XB_TOP], 1u);
            const unsigned tg = og / nx;
            if (og + 1u == (tg + 1u) * nx) xb_add(&bar[XB_TOPGEN], 1u);
            else XB_SPIN(xb_ld(&bar[XB_TOPGEN]) == tg, bar);
            __builtin_amdgcn_fence(__ATOMIC_ACQUIRE, "agent");
            xb_add(&bar[XB_XGEN(b.x)], 1u);
            asm volatile("s_waitcnt vmcnt(0)" ::: "memory");
        } else {
            XB_SPIN(xb_ld(&bar[XB_XGEN(b.x)]) == gen, bar);
            __builtin_amdgcn_fence(__ATOMIC_ACQUIRE, "agent");
            asm volatile("s_waitcnt vmcnt(0)" ::: "memory");
        }
    }
    __syncthreads();
}

struct Frame {
    LAS unsigned char* lds;
    volatile LAS unsigned* MISC;
    gu32* ctl;
    int tid, lane, wave;
    int G;
    unsigned char* ws;
    float* out;
};
enum { I_X = 0, I_NORMG, I_FFN_IN, I_FFN_OUT, I_ML_IN, I_ML_IB, I_ML_FB, I_ML_HG, I_ML_OUT, I_GD_IN, I_GD_CONV, I_GD_ALOG, I_GD_DTB, I_GD_NG, I_GD_OUT };
constexpr int PTR_OFF = MISC_OFF + 128;
static_assert(PTR_OFF + 15 * 8 <= LDS_BYTES, "LDS map");
__device__ __forceinline__ const float* inp(const Frame& F, int i) {
    volatile LAS unsigned* p = (volatile LAS unsigned*)(F.lds + PTR_OFF) + 2 * i;
    const unsigned lo = __builtin_amdgcn_readfirstlane(p[0]), hi = __builtin_amdgcn_readfirstlane(p[1]);
    return (const float*)(((unsigned long long)hi << 32) | lo);
}
__device__ __forceinline__ void relaunder(Frame& F) { int t = threadIdx.x; asm volatile("" : "+v"(t)); F.tid = t; F.lane = t & 63; F.wave = __builtin_amdgcn_readfirstlane(t >> 6); }

__device__ __forceinline__ float wave_sum(float v) {
#pragma unroll
    for (int o = 1; o < 64; o <<= 1) v += __shfl_xor(v, o);
    return v;
}

__device__ __forceinline__ void tr_item(const float* W, int ldw, bf16* WT, int K, LAS float* scr, int lane) {
#pragma unroll 8
    for (int i = 0; i < 32; ++i) { const int kk = 2 * i + (lane >> 5); scr[kk * 33 + (lane & 31)] = ((const GAS float*)W)[(size_t)kk * ldw + (lane & 31)]; }
    LDS_WAIT(); asm volatile("" ::: "memory");
    const int c = lane & 7;
#pragma unroll
    for (int j = 0; j < 4; ++j) { const int n = (lane >> 3) + 8 * j; const LAS float* s = scr + (8 * c) * 33 + n;
        v4u o; o.x = pk2(s[0 * 33], s[1 * 33]); o.y = pk2(s[2 * 33], s[3 * 33]); o.z = pk2(s[4 * 33], s[5 * 33]); o.w = pk2(s[6 * 33], s[7 * 33]);
        *(GAS v4u*)(WT + (size_t)n * K + 8 * c) = o; }
    LDS_WAIT(); asm volatile("" ::: "memory");
}

__device__ __forceinline__ void row_store_hn(const f32x4 (&h)[8], const float* gain, bf16* orow, int lane) {
    float ss = 0.f;
#pragma unroll
    for (int j = 0; j < 8; ++j) ss += (h[j].x * h[j].x + h[j].y * h[j].y) + (h[j].z * h[j].z + h[j].w * h[j].w);
    const float rstd = 1.0f / sqrtf(wave_sum(ss) * (1.0f / D) + EPS);
    GAS v2u* o8 = (GAS v2u*)orow + lane;
    const GAS f32x4* gp = (const GAS f32x4*)gain + lane;
#pragma unroll
    for (int j = 0; j < 8; ++j) { const f32x4 g = gp[64 * j]; v2u w; w.x = pk2(h[j].x * rstd * g.x, h[j].y * rstd * g.y); w.y = pk2(h[j].z * rstd * g.z, h[j].w * rstd * g.w); o8[64 * j] = w; }
}

__device__ __forceinline__ void prologue(Frame& F) {
    LAS float* scr = (LAS float*)(F.lds + RING_OFF + F.wave * 16384);
    const int gw = blockIdx.x * NWAVES + F.wave, NGW = F.G * NWAVES;
    constexpr int I_A = 32 * 344, I_B = 86 * 64, I_C = 32 * 192, I_D = 32 * 64, I_E = 32 * 384, I_F = 64 * 64;
    constexpr int NITEMS = 8 * I_A + 8 * I_B + 2 * I_C + 2 * I_D + 2 * I_E + 2 * I_F;
    for (int it = gw; it < NITEMS; it += NGW) {
        int r = it;
        if (r < 8 * I_A) { const int inst = r / I_A; r -= inst * I_A; const int kb = r / 344, nb = r % 344; const int n0 = 32 * nb;
            const int nn = n0 < DFF ? n0 : n0 - DFF; const int drow = 256 * (nn / 128) + (nn % 128) + (n0 < DFF ? 0 : 128);
            tr_item(inp(F, I_FFN_IN) + (size_t)inst * D * NFF1 + (size_t)(64 * kb) * NFF1 + n0, NFF1, (bf16*)(F.ws + WS_W1 + inst * SZ_W1) + (size_t)drow * D + 64 * kb, D, scr, F.lane); continue; }
        r -= 8 * I_A;
        if (r < 8 * I_B) { const int inst = r / I_B; r -= inst * I_B; const int kb = r / 64, nb = r % 64;
            tr_item(inp(F, I_FFN_OUT) + (size_t)inst * DFF * D + (size_t)(64 * kb) * D + 32 * nb, D, (bf16*)(F.ws + WS_W2 + inst * SZ_W2) + (size_t)(32 * nb) * DFF + 64 * kb, DFF, scr, F.lane); continue; }
        r -= 8 * I_B;
        if (r < 2 * I_C) { const int inst = r / I_C; r -= inst * I_C; const int kb = r / 192, nb = r % 192;
            tr_item(inp(F, I_ML_IN) + (size_t)inst * D * ML_IN + (size_t)(64 * kb) * ML_IN + 32 * nb, ML_IN, (bf16*)(F.ws + WS_MLIN + inst * SZ_MLIN) + (size_t)(32 * nb) * D + 64 * kb, D, scr, F.lane); continue; }
        r -= 2 * I_C;
        if (r < 2 * I_D) { const int inst = r / I_D; r -= inst * I_D; const int kb = r / 64, nb = r % 64;
            tr_item(inp(F, I_ML_OUT) + (size_t)inst * ML_V * D + (size_t)(64 * kb) * D + 32 * nb, D, (bf16*)(F.ws + WS_MLOUT + inst * SZ_MLOUT) + (size_t)(32 * nb) * ML_V + 64 * kb, ML_V, scr, F.lane); continue; }
        r -= 2 * I_D;
        if (r < 2 * I_E) { const int inst = r / I_E; r -= inst * I_E; const int kb = r / 384, nb = r % 384;
            tr_item(inp(F, I_GD_IN) + (size_t)inst * D * GD_IN + (size_t)(64 * kb) * GD_IN + 32 * nb, GD_IN, (bf16*)(F.ws + WS_GDIN + inst * SZ_GDIN) + (size_t)(32 * nb) * D + 64 * kb, D, scr, F.lane); continue; }
        r -= 2 * I_E;
        { const int inst = r / I_F; r -= inst * I_F; const int kb = r / 64, nb = r % 64;
            tr_item(inp(F, I_GD_OUT) + (size_t)inst * GD_VTOT * D + (size_t)(64 * kb) * D + 32 * nb, D, (bf16*)(F.ws + WS_GDOUT + inst * SZ_GDOUT) + (size_t)(32 * nb) * GD_VTOT + 64 * kb, GD_VTOT, scr, F.lane); }
    }
    { const int gt = blockIdx.x * (NWAVES * 64) + F.tid, NGT = F.G * NWAVES * 64;
      for (int i = gt; i < 2 * 16 * D; i += NGT) { const int inst = i / (16 * D), rr = (i / D) % 16, k = i % D;
          const float v = rr < 8 ? inp(F, I_ML_IN)[(size_t)inst * D * ML_IN + (size_t)k * ML_IN + ML_N + rr] : 0.f; ((bf16*)(F.ws + WS_MLX))[i] = (bf16)f2bf(v); }
      for (int i = gt; i < 2 * 64 * D; i += NGT) { const int inst = i / (64 * D), rr = (i / D) % 64, k = i % D;
          ((bf16*)(F.ws + WS_GDX))[i] = (bf16)f2bf(inp(F, I_GD_IN)[(size_t)inst * D * GD_IN + (size_t)k * GD_IN + GD_N + rr]); } }
    for (int m = gw; m < M; m += NGW) {
        const GAS f32x4* xr = (const GAS f32x4*)(inp(F, I_X) + (size_t)m * D) + F.lane; GAS f32x4* hr = (GAS f32x4*)(F.out + (size_t)m * D) + F.lane;
        f32x4 h[8];
#pragma unroll
        for (int j = 0; j < 8; ++j) { h[j] = xr[64 * j]; hr[64 * j] = h[j]; }
        row_store_hn(h, inp(F, I_NORMG), (bf16*)(F.ws + WS_HN) + (size_t)m * D, F.lane);
    }
}

__device__ __forceinline__ void norm_phase(Frame& F, float alpha, const float* gpost, const float* gpre, bool write_hn) {
    const int gw = blockIdx.x * NWAVES + F.wave, NGW = F.G * NWAVES;
    const bf16* Y = (const bf16*)(F.ws + WS_Y);
    for (int m = gw; m < M; m += NGW) {
        const GAS v2u* yr = (const GAS v2u*)(Y + (size_t)m * D) + F.lane; GAS f32x4* hr = (GAS f32x4*)(F.out + (size_t)m * D) + F.lane;
        const GAS f32x4* gp = (const GAS f32x4*)gpost + F.lane;
        f32x4 y[8], h[8]; float ss = 0.f;
#pragma unroll
        for (int j = 0; j < 8; ++j) { const v2u yy = yr[64 * j]; y[j] = (f32x4){bflo(yy.x), bfhi(yy.x), bflo(yy.y), bfhi(yy.y)}; h[j] = hr[64 * j]; ss += (y[j].x * y[j].x + y[j].y * y[j].y) + (y[j].z * y[j].z + y[j].w * y[j].w); }
        const float rs = alpha / sqrtf(wave_sum(ss) * (1.0f / D) + EPS);
#pragma unroll
        for (int j = 0; j < 8; ++j) { const f32x4 g = gp[64 * j]; h[j] = h[j] + (y[j] * rs) * g; hr[64 * j] = h[j]; }
        if (write_hn) row_store_hn(h, gpre, (bf16*)(F.ws + WS_HN) + (size_t)m * D, F.lane);
    }
}

template <int NT> __device__ __forceinline__ void skinny_phase(Frame& F, const bf16* Wx, float* out) {
    const int lane = F.lane, fr = lane & 15, fq = lane >> 4, w = F.wave, g = w >> 2, kq = w & 3;
    const bf16* A = (const bf16*)(F.ws + WS_HN);
    LAS f32x4* red = (LAS f32x4*)F.lds;
    for (int u = blockIdx.x; u < M / 32; u += F.G) {
        f32x4 acc[NT];
#pragma unroll
        for (int n = 0; n < NT; ++n) acc[n] = (f32x4){0.f, 0.f, 0.f, 0.f};
        const int r0 = 32 * u + 16 * g;
        const bf16* ap = A + (size_t)(r0 + fr) * D + kq * 512 + fq * 8; const bf16* bp = Wx + (size_t)fr * D + kq * 512 + fq * 8;
#pragma unroll 8
        for (int ks = 0; ks < 16; ++ks) {
            const bf16x8 a = *(const GAS bf16x8*)(ap + ks * 32);
#pragma unroll
            for (int n = 0; n < NT; ++n) { const bf16x8 b = *(const GAS bf16x8*)(bp + (size_t)n * 16 * D + ks * 32); acc[n] = __builtin_amdgcn_mfma_f32_16x16x32_bf16(a, b, acc[n], 0, 0, 0); }
        }
        __syncthreads();
#pragma unroll
        for (int n = 0; n < NT; ++n) red[(w * NT + n) * 64 + lane] = acc[n];
        __syncthreads();
        if (kq == 0) {
#pragma unroll
            for (int n = 0; n < NT; ++n) { f32x4 s = red[(w * NT + n) * 64 + lane] + red[((w + 1) * NT + n) * 64 + lane] + red[((w + 2) * NT + n) * 64 + lane] + red[((w + 3) * NT + n) * 64 + lane];
#pragma unroll
                for (int j = 0; j < 4; ++j) out[(size_t)(r0 + fq * 4 + j) * (16 * NT) + n * 16 + fr] = s[j]; }
        }
    }
    __syncthreads();
}

__device__ __forceinline__ float softcap15(float x) { return 15.0f * tanhf(x * (1.0f / 15.0f)); }
__device__ __forceinline__ float logsigmoid_f(float x) { return x >= 0.f ? -log1pf(expf(-x)) : x - log1pf(expf(x)); }
__device__ __forceinline__ float softplus_f(float x) { return x > 20.f ? x : log1pf(expf(x)); }
__device__ __forceinline__ float sigmoid_f(float x) { return 1.0f / (1.0f + expf(-x)); }

typedef short v4i16_t __attribute__((ext_vector_type(4)));
__device__ __forceinline__ bf16x8 ldsfrag(const LAS unsigned char* base, int row, int pitchB, int kbyte) { return *(const LAS bf16x8*)(base + row * pitchB + kbyte); }
__device__ __forceinline__ bf16x8 ldsfrag_tr(const LAS unsigned char* base, int pitchB, int k0, int n0, int lane) {
    const int g = lane >> 4, q = (lane & 15) >> 2, p = lane & 3;
    const LAS unsigned char* a = base + (k0 + 8 * g + q) * pitchB + (n0 + 4 * p) * 2;
    const v4i16_t lo = __builtin_amdgcn_ds_read_tr16_b64_v4i16((LAS v4i16_t*)a);
    const v4i16_t hi = __builtin_amdgcn_ds_read_tr16_b64_v4i16((LAS v4i16_t*)(a + 4 * pitchB));
    return (bf16x8){lo.x, lo.y, lo.z, lo.w, hi.x, hi.y, hi.z, hi.w};
}
__device__ __forceinline__ float wave_max(float v) {
#pragma unroll
    for (int o = 1; o < 64; o <<= 1) v = fmaxf(v, __shfl_xor(v, o));
    return v;
}
#ifndef MLREPB
#define MLREPB 1
#endif
#ifndef MLREPC
#define MLREPC 1
#endif
__device__ __forceinline__ void ml_scan_fast(Frame& F, int j) {
    constexpr int PQ = 528, PS = 144, PV = 112;
    LAS unsigned char* Qs = F.lds;
    LAS unsigned char* Ks = Qs + 33792;
    LAS unsigned char* CT = Ks + 33792;
    LAS unsigned char* Ss = CT + 25344;
    LAS unsigned char* Vs = Ss + 9216;
    LAS unsigned char* Vw = Vs + 7168;
    LAS float* gU1 = (LAS float*)(Vw + 7168);
    LAS float* gU2 = gU1 + 64;
    LAS float* gInter = gU2 + 64;
    LAS float* gEm = gInter + 64;
    LAS float* gW = gEm + 64;
    LAS float* gDecay = gW + 64;
    LAS float* cBl = gDecay + 64;
    LAS float* cMx = cBl + 32;
    LAS float* cM = cMx + 32;
    const bf16* P = (const bf16*)(F.ws + WS_PROJ); const float* GT = (const float*)(F.ws + WS_GATES); bf16* O = (bf16*)(F.ws + WS_SCAN);
    float* GS = (float*)(F.ws + WS_ACT);
    const int tid_o = F.tid, w = F.wave;
    for (int item = blockIdx.x; item < BATCH * ML_H * 16; item += F.G) {
        const int b = item / (ML_H * 16), hh = (item / 16) % ML_H, sl = item % 16;
        const size_t rowb = (size_t)b * SEQ;
        __syncthreads();
        {
            const int lane = tid_o & 63;
            const float ib = inp(F, I_ML_IB)[j * ML_H + hh], fb = inp(F, I_ML_FB)[j * ML_H + hh];
            float bcA[4], u2A[4], pmA[4];
#pragma unroll
            for (int i = 0; i < 4; ++i) { const int c = 4 * w + i; const size_t row = rowb + (size_t)c * 64 + lane;
                const float ipre = GT[row * 16 + hh], fpre = GT[row * 16 + 4 + hh];
                const float il = 15.0f * ftanh((ipre + ib) * (1.0f / 15.0f)), fl = -flog(1.0f + fexp(-15.0f * ftanh((fpre + fb) * (1.0f / 15.0f))));
                float bc = fl;
#pragma unroll
                for (int o = 1; o < 64; o <<= 1) { const float y = __shfl_up(bc, o); if (lane >= o) bc += y; }
                const float u2 = il - bc; float pm = u2;
#pragma unroll
                for (int o = 1; o < 64; o <<= 1) { const float y = __shfl_up(pm, o); if (lane >= o) pm = fmaxf(pm, y); }
                const float blast = __shfl(bc, 63); const float mx = wave_max(blast + u2);
                bcA[i] = bc; u2A[i] = u2; pmA[i] = pm; if (lane == 0) { cBl[c] = blast; cMx[c] = mx; } }
            __syncthreads();
            if (tid_o == 0) { float m = 0.f; for (int c = 0; c < 32; ++c) { cM[c] = m; m = fmaxf(cBl[c] + m, cMx[c]); } cM[32] = m; }
            __syncthreads();
#pragma unroll
            for (int i = 0; i < 4; ++i) { const int c = 4 * w + i; const float mc = cM[c], mn = cM[c + 1], blast = cBl[c];
                const float linter = bcA[i] + mc, mt = fmaxf(linter, bcA[i] + pmA[i]);
                float* g = GS + ((size_t)(item * 32 + c) * 6) * 64 + lane;
                g[0] = bcA[i] - mt - 2.772588722239781f; g[64] = u2A[i]; g[128] = fexp(linter - mt) * 0.0625f; g[192] = fexp(-mt); g[256] = fexp(blast + u2A[i] - mn); g[320] = fexp(blast + mc - mn); }
            for (int o = tid_o; o < 25344 / 4; o += 512) ((LAS unsigned*)CT)[o] = 0u;
            if (tid_o < 64) { *(LAS v4u*)(Vs + tid_o * PV + 64) = (v4u){0x00003F80u, 0u, 0u, 0u}; *(LAS v4u*)(Vs + tid_o * PV + 80) = (v4u){0u, 0u, 0u, 0u}; *(LAS v4u*)(Vs + tid_o * PV + 96) = (v4u){0u, 0u, 0u, 0u};
                              *(LAS v4u*)(Vw + tid_o * PV + 64) = (v4u){0u, 0u, 0u, 0u}; *(LAS v4u*)(Vw + tid_o * PV + 80) = (v4u){0u, 0u, 0u, 0u}; *(LAS v4u*)(Vw + tid_o * PV + 96) = (v4u){0u, 0u, 0u, 0u}; }
            VM_WAIT();
            __syncthreads();
        }
        f32x4 Cacc[2][3];
#pragma unroll
        for (int a = 0; a < 2; ++a)
#pragma unroll
            for (int c = 0; c < 3; ++c) Cacc[a][c] = (f32x4){0.f, 0.f, 0.f, 0.f};
        v4u qreg[4], kreg[4], vreg; float gpre = 0.f;
#define ML_PREFETCH(c_) do { const size_t r0_ = rowb + (size_t)(c_) * 64; \
            _Pragma("unroll") for (int i_ = 0; i_ < 4; ++i_) { const int p_ = tid_o + 512 * i_, rr_ = p_ >> 5, sg_ = p_ & 31; \
                qreg[i_] = *(const GAS v4u*)(P + (r0_ + rr_) * ML_N + hh * ML_DQK + sg_ * 8); kreg[i_] = *(const GAS v4u*)(P + (r0_ + rr_) * ML_N + ML_QK + hh * ML_DQK + sg_ * 8); } \
            if (tid_o < 256) vreg = *(const GAS v4u*)(P + (r0_ + (tid_o >> 2)) * ML_N + 2 * ML_QK + hh * ML_DV + sl * 32 + (tid_o & 3) * 8); \
            if (tid_o < 384) gpre = __hip_atomic_load(GS + (size_t)(item * 32 + (c_)) * 384 + tid_o, RLX_AGENT); } while (0)
        ML_PREFETCH(0);
        for (int c = 0; c < SEQ / 64; ++c) {
            int tid = tid_o; asm volatile("" : "+v"(tid)); const int lane = tid & 63, fr = lane & 15, fq = lane >> 4;
            const size_t row0 = rowb + (size_t)c * 64;
#pragma unroll
            for (int i = 0; i < 4; ++i) { const int p = tid + 512 * i, rr = p >> 5, sg = p & 31; *(LAS v4u*)(Qs + rr * PQ + sg * 16) = qreg[i]; *(LAS v4u*)(Ks + rr * PQ + sg * 16) = kreg[i]; }
            if (tid < 256) *(LAS v4u*)(Vs + (tid >> 2) * PV + (tid & 3) * 16) = vreg;
            if (tid < 384) gU1[tid] = gpre;
            const v4u vkeep = vreg;
            if (c + 1 < SEQ / 64) ML_PREFETCH(c + 1);
            __syncthreads();
            for (int rpB = 0; rpB < MLREPB; ++rpB) {
            if (tid < 256) { const int rr = tid >> 2; const float ws = gW[rr]; v4u o;
                o.x = pk2(bflo(vkeep.x) * ws, bfhi(vkeep.x) * ws); o.y = pk2(bflo(vkeep.y) * ws, bfhi(vkeep.y) * ws); o.z = pk2(bflo(vkeep.z) * ws, bfhi(vkeep.z) * ws); o.w = pk2(bflo(vkeep.w) * ws, bfhi(vkeep.w) * ws);
                *(LAS v4u*)(Vw + rr * PV + (tid & 3) * 16) = o; if ((tid & 3) == 0) *(LAS unsigned short*)(Vw + rr * PV + 64) = bf1(ws); }
            { const int lt = w >> 1, ct0 = 2 * (w & 1); f32x4 sa0 = (f32x4){0.f, 0.f, 0.f, 0.f}, sa1 = sa0;
#pragma unroll
              for (int ks = 0; ks < 8; ++ks) { const bf16x8 a = ldsfrag(Qs, lt * 16 + fr, PQ, ks * 64 + fq * 16), b0 = ldsfrag(Ks, ct0 * 16 + fr, PQ, ks * 64 + fq * 16), b1 = ldsfrag(Ks, (ct0 + 1) * 16 + fr, PQ, ks * 64 + fq * 16);
                  sa0 = __builtin_amdgcn_mfma_f32_16x16x32_bf16(a, b0, sa0, 0, 0, 0); sa1 = __builtin_amdgcn_mfma_f32_16x16x32_bf16(a, b1, sa1, 0, 0, 0); }
#pragma unroll
              for (int t = 0; t < 2; ++t) { const int sp = (ct0 + t) * 16 + fr; const float u2 = gU2[sp];
#pragma unroll
                  for (int jj = 0; jj < 4; ++jj) { const int l = lt * 16 + fq * 4 + jj; const float sv = (t == 0 ? sa0[jj] : sa1[jj]); const float val = sp <= l ? sv * fexp(gU1[l] + u2) : 0.f;
                      *(LAS unsigned short*)(Ss + l * PS + sp * 2) = bf1(val); } } }
            __syncthreads();
            }
            for (int rpC = 0; rpC < MLREPC; ++rpC) {
            { const int lt = w >> 1, et = w & 1; f32x4 n0 = (f32x4){0.f, 0.f, 0.f, 0.f}, n1 = n0;
#pragma unroll
              for (int ks = 0; ks < 8; ++ks) { const bf16x8 a = ldsfrag(Qs, lt * 16 + fr, PQ, ks * 64 + fq * 16), b0 = ldsfrag(CT, et * 16 + fr, PQ, ks * 64 + fq * 16), b1 = ldsfrag(CT, 32 + fr, PQ, ks * 64 + fq * 16);
                  n0 = __builtin_amdgcn_mfma_f32_16x16x32_bf16(a, b0, n0, 0, 0, 0); n1 = __builtin_amdgcn_mfma_f32_16x16x32_bf16(a, b1, n1, 0, 0, 0); }
#pragma unroll
              for (int jj = 0; jj < 4; ++jj) { const float it = gInter[lt * 16 + fq * 4 + jj]; n0[jj] *= it; n1[jj] *= it; }
#pragma unroll
              for (int ks = 0; ks < 2; ++ks) { const bf16x8 a = ldsfrag(Ss, lt * 16 + fr, PS, ks * 64 + fq * 16), b0 = ldsfrag_tr(Vs, PV, ks * 32, et * 16, lane), b1 = ldsfrag_tr(Vs, PV, ks * 32, 32, lane);
                  n0 = __builtin_amdgcn_mfma_f32_16x16x32_bf16(a, b0, n0, 0, 0, 0); n1 = __builtin_amdgcn_mfma_f32_16x16x32_bf16(a, b1, n1, 0, 0, 0); }
#pragma unroll
              for (int jj = 0; jj < 4; ++jj) { const int l = lt * 16 + fq * 4 + jj; const float den = __shfl(n1[jj], lane & 48);
                  O[(row0 + l) * ML_V + hh * ML_DV + sl * 32 + et * 16 + fr] = bf1(n0[jj] * frcp(fmaxf(fabsf(den), gEm[l]))); } }
            __syncthreads();
            }
            { const float dc = gDecay[0];
#pragma unroll
              for (int a = 0; a < 2; ++a)
#pragma unroll
                  for (int e = 0; e < 3; ++e) Cacc[a][e] = Cacc[a][e] * dc;
#pragma unroll
              for (int ks = 0; ks < 2; ++ks) { const bf16x8 a0 = ldsfrag_tr(Ks, PQ, ks * 32, (2 * w) * 16, lane), a1 = ldsfrag_tr(Ks, PQ, ks * 32, (2 * w + 1) * 16, lane);
#pragma unroll
                  for (int e = 0; e < 3; ++e) { const bf16x8 bb = ldsfrag_tr(Vw, PV, ks * 32, e * 16, lane);
                      Cacc[0][e] = __builtin_amdgcn_mfma_f32_16x16x32_bf16(a0, bb, Cacc[0][e], 0, 0, 0); Cacc[1][e] = __builtin_amdgcn_mfma_f32_16x16x32_bf16(a1, bb, Cacc[1][e], 0, 0, 0); } }
#pragma unroll
              for (int a = 0; a < 2; ++a)
#pragma unroll
                  for (int e = 0; e < 3; ++e) { const f32x4 v = Cacc[a][e]; v2u pk; pk.x = pk2(v[0], v[1]); pk.y = pk2(v[2], v[3]);
                      *(LAS v2u*)(CT + (e * 16 + fr) * PQ + ((2 * w + a) * 16 + fq * 4) * 2) = pk; } }
            __syncthreads();
        }
#undef ML_PREFETCH
    }
}

__device__ __forceinline__ void ml_gate_phase(Frame& F, int j) {
    const int gw = blockIdx.x * NWAVES + F.wave, NGW = F.G * NWAVES;
    const bf16* S = (const bf16*)(F.ws + WS_SCAN); const bf16* P = (const bf16*)(F.ws + WS_PROJ); bf16* Yo = (bf16*)(F.ws + WS_YMIX);
    for (int m = gw; m < M; m += NGW) {
#pragma unroll
        for (int hh = 0; hh < ML_H; ++hh) {
            const GAS v4u* sr = (const GAS v4u*)(S + (size_t)m * ML_V + hh * ML_DV) + F.lane;
            const v4u sv = sr[0];
            float a[8] = {bflo(sv.x), bfhi(sv.x), bflo(sv.y), bfhi(sv.y), bflo(sv.z), bfhi(sv.z), bflo(sv.w), bfhi(sv.w)};
            float ss = 0.f;
#pragma unroll
            for (int i = 0; i < 8; ++i) ss += a[i] * a[i];
            const float rstd = __builtin_amdgcn_rsqf(wave_sum(ss) * (1.0f / ML_DV) + EPS);
            const GAS f32x4* gp = (const GAS f32x4*)(inp(F, I_ML_HG) + (size_t)(j * ML_H + hh) * ML_DV) + 2 * F.lane;
            const f32x4 g0 = gp[0], g1 = gp[1]; const float g[8] = {g0.x, g0.y, g0.z, g0.w, g1.x, g1.y, g1.z, g1.w};
            const v4u ov = *((const GAS v4u*)(P + (size_t)m * ML_N + 2 * ML_QK + ML_V + hh * ML_DV) + F.lane);
            const float o[8] = {bflo(ov.x), bfhi(ov.x), bflo(ov.y), bfhi(ov.y), bflo(ov.z), bfhi(ov.z), bflo(ov.w), bfhi(ov.w)};
            v4u w;
            w.x = pk2(fsigmoid(o[0]) * a[0] * rstd * g[0], fsigmoid(o[1]) * a[1] * rstd * g[1]); w.y = pk2(fsigmoid(o[2]) * a[2] * rstd * g[2], fsigmoid(o[3]) * a[3] * rstd * g[3]);
            w.z = pk2(fsigmoid(o[4]) * a[4] * rstd * g[4], fsigmoid(o[5]) * a[5] * rstd * g[5]); w.w = pk2(fsigmoid(o[6]) * a[6] * rstd * g[6], fsigmoid(o[7]) * a[7] * rstd * g[7]);
            *((GAS v4u*)(Yo + (size_t)m * ML_V + hh * ML_DV) + F.lane) = w;
        }
    }
}

__device__ __forceinline__ f32x4 mm16_f32(f32x4 acc, const LAS float* A, int lda, const LAS float* B, int ldb, int K, int fr, int fq) {
#pragma unroll
    for (int k0 = 0; k0 < K; k0 += 4) { const float a = A[fr * lda + k0 + fq]; const float b = B[(k0 + fq) * ldb + fr]; acc = __builtin_amdgcn_mfma_f32_16x16x4f32(a, b, acc, 0, 0, 0); }
    return acc;
}
__device__ __forceinline__ void gdn_scan_fast(Frame& F, int j) {
    constexpr int P8 = 272, P4 = 144;
    LAS unsigned char* const L0 = F.lds;
    LAS float* AM = (LAS float*)(L0);
    LAS unsigned char* TBb = L0, * T2b = L0 + 9216;
    LAS float* TM = (LAS float*)(L0 + 18432);
    LAS unsigned char* VN2 = L0 + 18432;
    LAS float* XM = (LAS float*)(L0 + 35072);
    LAS unsigned char* QU = L0 + 39296;
    LAS unsigned char* KU = QU + 17408;
    LAS unsigned char* KUT = KU + 17408;
    LAS unsigned char* VBT = KUT + 18432;
    LAS unsigned char* QKM = VBT + 9216;
    LAS unsigned char* ST = QKM + 9216;
    LAS float* sGC = (LAS float*)(ST + 17408);
    LAS float* sBeta = sGC + 64; LAS float* sRq = sBeta + 64; LAS float* sRk = sRq + 64;
    static_assert(39296 + 17408 * 2 + 18432 + 9216 * 2 + 17408 + 1024 <= RING_BYTES, "gdn LDS map");
    const bf16* P = (const bf16*)(F.ws + WS_PROJ); const float* GT = (const float*)(F.ws + WS_GATES); bf16* O = (bf16*)(F.ws + WS_SCAN);
    const float* CW = inp(F, I_GD_CONV) + (size_t)j * 4 * GD_CONVCH;
    const int tid_o = F.tid, lane_o = F.lane, w = F.wave;
    for (int item = blockIdx.x; item < BATCH * GD_HV * 2; item += F.G) {
        const int b = item / (GD_HV * 2), hv = (item >> 1) % GD_HV, half = item & 1, hk = hv >> 1;
        const float Aexp = fexp(inp(F, I_GD_ALOG)[j * GD_HV + hv]), dtb = inp(F, I_GD_DTB)[j * GD_HV + hv];
        const size_t rowb = (size_t)b * SEQ;
        const int rs = w < 6 ? (w % 3) * 21 : 16 * (2 * (w - 6) + (lane_o >> 5));
        const int chb = w < 3 ? hk * 128 + 2 * lane_o : (w < 6 ? 2048 + hk * 128 + 2 * lane_o : 4096 + hv * 128 + half * 64 + 2 * (lane_o & 31));
        float cw0[4], cw1[4];
#pragma unroll
        for (int tp = 0; tp < 4; ++tp) { cw0[tp] = CW[tp * GD_CONVCH + chb]; cw1[tp] = CW[tp * GD_CONVCH + chb + 1]; }
        __syncthreads();
        for (int o = tid_o; o < 17408 / 4; o += 512) ((LAS unsigned*)ST)[o] = 0u;
        f32x4 Sacc[4];
#pragma unroll
        for (int e = 0; e < 4; ++e) Sacc[e] = (f32x4){0.f, 0.f, 0.f, 0.f};
        unsigned xr[25]; float bp[16]; float ga = 0.f, gb = 0.f;
#define GD_PREFETCH(c_) do { const int lane = lane_o; const int tb_ = (c_) * 64 + rs - 3; const GAS unsigned char* pp_ = (const GAS unsigned char*)(P + (rowb + tb_) * GD_N + chb); \
            if (w < 6) { _Pragma("unroll") for (int i_ = 0; i_ < 25; ++i_) { const unsigned x_ = *(const GAS unsigned*)pp_; xr[i_] = (tb_ + i_ >= 0) ? x_ : 0u; pp_ += GD_N * 2; asm volatile("" : "+v"(pp_)); } } \
            else { _Pragma("unroll") for (int i_ = 0; i_ < 19; ++i_) { const unsigned x_ = *(const GAS unsigned*)pp_; xr[i_] = (tb_ + i_ >= 0) ? x_ : 0u; pp_ += GD_N * 2; asm volatile("" : "+v"(pp_)); } \
                   const GAS float* gp_ = (const GAS float*)(GT + (rowb + (c_) * 64 + rs) * 64 + hv); \
                   _Pragma("unroll") for (int i_ = 0; i_ < 16; ++i_) bp[i_] = gp_[i_ * 64]; \
                   if (w == 7) { ga = GT[(rowb + (c_) * 64 + lane) * 64 + 32 + hv]; gb = GT[(rowb + (c_) * 64 + lane) * 64 + hv]; } } } while (0)
        GD_PREFETCH(0);
        for (int c = 0; c < SEQ / 64; ++c) {
            int tid = tid_o; asm volatile("" : "+v"(tid)); const int lane = tid & 63, fr = lane & 15, fq = lane >> 4;
            const size_t row0 = rowb + (size_t)c * 64;
            if (w < 6) {
                const bool isk = w >= 3; LAS unsigned char* dst = isk ? KU : QU;
#pragma unroll
                for (int i = 0; i < 22; ++i) { const int r = rs + i; float y0 = 0.f, y1 = 0.f;
#pragma unroll
                    for (int tp = 0; tp < 4; ++tp) { y0 += cw0[tp] * bflo(xr[i + tp]); y1 += cw1[tp] * bfhi(xr[i + tp]); }
                    y0 = y0 * fsigmoid(y0); y1 = y1 * fsigmoid(y1);
                    const unsigned pk = pk2(y0, y1);
                    *(LAS unsigned*)(dst + r * P8 + lane * 4) = pk;
                    if (isk) { *(LAS unsigned short*)(KUT + (2 * lane) * P4 + r * 2) = (unsigned short)(pk & 0xffffu); *(LAS unsigned short*)(KUT + (2 * lane + 1) * P4 + r * 2) = (unsigned short)(pk >> 16); } }
            } else {
                const int vp = lane & 31;
#pragma unroll
                for (int i = 0; i < 16; ++i) { const int r = rs + i; float y0 = 0.f, y1 = 0.f;
#pragma unroll
                    for (int tp = 0; tp < 4; ++tp) { y0 += cw0[tp] * bflo(xr[i + tp]); y1 += cw1[tp] * bfhi(xr[i + tp]); }
                    const float bt = fsigmoid(bp[i]);
                    y0 = y0 * fsigmoid(y0) * bt; y1 = y1 * fsigmoid(y1) * bt;
                    const unsigned pk = pk2(y0, y1);
                    *(LAS unsigned short*)(VBT + (2 * vp) * P4 + r * 2) = (unsigned short)(pk & 0xffffu); *(LAS unsigned short*)(VBT + (2 * vp + 1) * P4 + r * 2) = (unsigned short)(pk >> 16); }
                if (w == 7) { const float xg = ga + dtb; float g = -Aexp * (xg > 15.f ? xg : flog(1.0f + fexp(xg)));
#pragma unroll
                    for (int o = 1; o < 64; o <<= 1) { const float y = __shfl_up(g, o); if (lane >= o) g += y; }
                    sGC[lane] = g; sBeta[lane] = fsigmoid(gb); }
            }
            if (c + 1 < SEQ / 64) GD_PREFETCH(c + 1);
            __syncthreads();
            { const int lt = w >> 1, ct0 = 2 * (w & 1); f32x4 kk0 = (f32x4){0.f, 0.f, 0.f, 0.f}, kk1 = kk0, qk0 = kk0, qk1 = kk0, kd = kk0, qd = kk0;
#pragma unroll
              for (int ks = 0; ks < 4; ++ks) { const bf16x8 aK = ldsfrag(KU, lt * 16 + fr, P8, ks * 64 + fq * 16), aQ = ldsfrag(QU, lt * 16 + fr, P8, ks * 64 + fq * 16);
                  const bf16x8 b0 = ldsfrag(KU, ct0 * 16 + fr, P8, ks * 64 + fq * 16), b1 = ldsfrag(KU, (ct0 + 1) * 16 + fr, P8, ks * 64 + fq * 16);
                  kk0 = __builtin_amdgcn_mfma_f32_16x16x32_bf16(aK, b0, kk0, 0, 0, 0); kk1 = __builtin_amdgcn_mfma_f32_16x16x32_bf16(aK, b1, kk1, 0, 0, 0);
                  qk0 = __builtin_amdgcn_mfma_f32_16x16x32_bf16(aQ, b0, qk0, 0, 0, 0); qk1 = __builtin_amdgcn_mfma_f32_16x16x32_bf16(aQ, b1, qk1, 0, 0, 0);
                  kd = __builtin_amdgcn_mfma_f32_16x16x32_bf16(aK, aK, kd, 0, 0, 0); qd = __builtin_amdgcn_mfma_f32_16x16x32_bf16(aQ, aQ, qd, 0, 0, 0); }
              if ((w & 1) == 0) {
#pragma unroll
                  for (int jj = 0; jj < 4; ++jj) if (fr == fq * 4 + jj) { sRk[lt * 16 + fr] = __builtin_amdgcn_rsqf(kd[jj] + EPS); sRq[lt * 16 + fr] = 0.08838834764831845f * __builtin_amdgcn_rsqf(qd[jj] + EPS); } }
              for (int o = tid; o < 64 * 65; o += 512) TM[o] = 0.f;
              __syncthreads();
#pragma unroll
              for (int t = 0; t < 2; ++t) { const int s = (ct0 + t) * 16 + fr; const float gs = sGC[s], rks = sRk[s];
#pragma unroll
                  for (int jj = 0; jj < 4; ++jj) { const int l = lt * 16 + fq * 4 + jj; const float e = s <= l ? fexp(sGC[l] - gs) : 0.f;
                      const float kv = t == 0 ? kk0[jj] : kk1[jj], qv = t == 0 ? qk0[jj] : qk1[jj];
                      AM[l * 68 + s] = s < l ? sBeta[l] * sRk[l] * rks * kv * e : 0.f;
                      *(LAS unsigned short*)(QKM + l * P4 + s * 2) = bf1(sRq[l] * rks * qv * e); } } }
            __syncthreads();
            if (w == 0) { float t[16]; const LAS float* Ab = AM + (16 * fq) * 68 + 16 * fq;
#pragma unroll
                for (int r = 0; r < 16; ++r) { float acc = (r == fr) ? 1.f : 0.f;
#pragma unroll
                    for (int q4 = 0; q4 < (r + 3) / 4; ++q4) { const f32x4 av = *(const LAS f32x4*)(Ab + r * 68 + 4 * q4);
#pragma unroll
                        for (int i = 0; i < 4; ++i) if (4 * q4 + i < r) acc -= av[i] * t[4 * q4 + i]; }
                    t[r] = acc; if (r == 8 || r == 12) asm volatile("" ::: "memory"); }
#pragma unroll
                for (int r = 0; r < 16; ++r) TM[(16 * fq + r) * 65 + 16 * fq + fr] = t[r]; }
            __syncthreads();
            if (w < 2) { const int o32 = 32 * w; LAS float* X = XM + w * 272;
                f32x4 x = mm16_f32((f32x4){0.f, 0.f, 0.f, 0.f}, AM + (o32 + 16) * 68 + o32, 68, TM + o32 * 65 + o32, 65, 16, fr, fq);
#pragma unroll
                for (int jj = 0; jj < 4; ++jj) X[(fq * 4 + jj) * 17 + fr] = x[jj];
                LDS_WAIT(); asm volatile("" ::: "memory");
                f32x4 y = mm16_f32((f32x4){0.f, 0.f, 0.f, 0.f}, TM + (o32 + 16) * 65 + o32 + 16, 65, X, 17, 16, fr, fq);
#pragma unroll
                for (int jj = 0; jj < 4; ++jj) TM[(o32 + 16 + fq * 4 + jj) * 65 + o32 + fr] = -y[jj]; }
            __syncthreads();
            if (w < 4) { const int ti = w >> 1, tj = w & 1;
                f32x4 x = mm16_f32((f32x4){0.f, 0.f, 0.f, 0.f}, AM + (32 + 16 * ti) * 68, 68, TM + 16 * tj, 65, 32, fr, fq);
#pragma unroll
                for (int jj = 0; jj < 4; ++jj) XM[(16 * ti + fq * 4 + jj) * 33 + 16 * tj + fr] = x[jj]; }
            __syncthreads();
            if (w < 4) { const int ti = w >> 1, tj = w & 1;
                f32x4 y = mm16_f32((f32x4){0.f, 0.f, 0.f, 0.f}, TM + (32 + 16 * ti) * 65 + 32, 65, XM + 16 * tj, 33, 32, fr, fq);
#pragma unroll
                for (int jj = 0; jj < 4; ++jj) TM[(32 + 16 * ti + fq * 4 + jj) * 65 + 16 * tj + fr] = -y[jj]; }
            __syncthreads();
            { const int s = tid & 63; const float cs = sBeta[s] * sRk[s] * fexp(sGC[s]);
#pragma unroll
              for (int i = 0; i < 8; ++i) { const int l = (tid >> 6) + 8 * i; const float tv = s <= l ? TM[l * 65 + s] : 0.f;
                  *(LAS unsigned short*)(TBb + l * P4 + s * 2) = bf1(tv); *(LAS unsigned short*)(T2b + l * P4 + s * 2) = bf1(tv * cs); } }
            __syncthreads();
            const int lt = w >> 1, et0 = 2 * (w & 1);
            f32x4 u0 = (f32x4){0.f, 0.f, 0.f, 0.f}, u1 = u0;
            { f32x4 wa[4];
#pragma unroll
              for (int q = 0; q < 4; ++q) wa[q] = (f32x4){0.f, 0.f, 0.f, 0.f};
              const int dt0 = 4 * (w & 1);
#pragma unroll
              for (int ks = 0; ks < 2; ++ks) { const bf16x8 a = ldsfrag(TBb, lt * 16 + fr, P4, ks * 64 + fq * 16), a2 = ldsfrag(T2b, lt * 16 + fr, P4, ks * 64 + fq * 16);
                  const bf16x8 b0 = ldsfrag(VBT, et0 * 16 + fr, P4, ks * 64 + fq * 16), b1 = ldsfrag(VBT, (et0 + 1) * 16 + fr, P4, ks * 64 + fq * 16);
                  u0 = __builtin_amdgcn_mfma_f32_16x16x32_bf16(a, b0, u0, 0, 0, 0); u1 = __builtin_amdgcn_mfma_f32_16x16x32_bf16(a, b1, u1, 0, 0, 0);
#pragma unroll
                  for (int q = 0; q < 4; ++q) { const bf16x8 bk = ldsfrag(KUT, (dt0 + q) * 16 + fr, P4, ks * 64 + fq * 16); wa[q] = __builtin_amdgcn_mfma_f32_16x16x32_bf16(a2, bk, wa[q], 0, 0, 0); } }
#pragma unroll
              for (int q = 0; q < 4; ++q)
#pragma unroll
                  for (int jj = 0; jj < 4; ++jj) *(LAS unsigned short*)(KU + (lt * 16 + fq * 4 + jj) * P8 + ((dt0 + q) * 16 + fr) * 2) = bf1(wa[q][jj]); }
            __syncthreads();
            f32x4 qs0 = (f32x4){0.f, 0.f, 0.f, 0.f}, qs1 = qs0;
            const float glast = sGC[63];
            { f32x4 p0 = (f32x4){0.f, 0.f, 0.f, 0.f}, p1 = p0;
#pragma unroll
              for (int ks = 0; ks < 4; ++ks) { const bf16x8 aW = ldsfrag(KU, lt * 16 + fr, P8, ks * 64 + fq * 16), aQ = ldsfrag(QU, lt * 16 + fr, P8, ks * 64 + fq * 16);
                  const bf16x8 b0 = ldsfrag(ST, et0 * 16 + fr, P8, ks * 64 + fq * 16), b1 = ldsfrag(ST, (et0 + 1) * 16 + fr, P8, ks * 64 + fq * 16);
                  p0 = __builtin_amdgcn_mfma_f32_16x16x32_bf16(aW, b0, p0, 0, 0, 0); p1 = __builtin_amdgcn_mfma_f32_16x16x32_bf16(aW, b1, p1, 0, 0, 0);
                  qs0 = __builtin_amdgcn_mfma_f32_16x16x32_bf16(aQ, b0, qs0, 0, 0, 0); qs1 = __builtin_amdgcn_mfma_f32_16x16x32_bf16(aQ, b1, qs1, 0, 0, 0); }
              const f32x4 vn0 = u0 - p0, vn1 = u1 - p1; const int l0 = lt * 16 + fq * 4;
              float c2[4];
#pragma unroll
              for (int jj = 0; jj < 4; ++jj) c2[jj] = sRk[l0 + jj] * fexp(glast - sGC[l0 + jj]);
              v2u pk; pk.x = pk2(vn0[0], vn0[1]); pk.y = pk2(vn0[2], vn0[3]); *(LAS v2u*)(VBT + (et0 * 16 + fr) * P4 + l0 * 2) = pk;
              pk.x = pk2(vn1[0], vn1[1]); pk.y = pk2(vn1[2], vn1[3]); *(LAS v2u*)(VBT + ((et0 + 1) * 16 + fr) * P4 + l0 * 2) = pk;
              pk.x = pk2(vn0[0] * c2[0], vn0[1] * c2[1]); pk.y = pk2(vn0[2] * c2[2], vn0[3] * c2[3]); *(LAS v2u*)(VN2 + (et0 * 16 + fr) * P4 + l0 * 2) = pk;
              pk.x = pk2(vn1[0] * c2[0], vn1[1] * c2[1]); pk.y = pk2(vn1[2] * c2[2], vn1[3] * c2[3]); *(LAS v2u*)(VN2 + ((et0 + 1) * 16 + fr) * P4 + l0 * 2) = pk; }
            __syncthreads();
            {
#pragma unroll
              for (int jj = 0; jj < 4; ++jj) { const int l = lt * 16 + fq * 4 + jj; const float f = sRq[l] * fexp(sGC[l]); qs0[jj] *= f; qs1[jj] *= f; }
#pragma unroll
              for (int ks = 0; ks < 2; ++ks) { const bf16x8 a = ldsfrag(QKM, lt * 16 + fr, P4, ks * 64 + fq * 16), b0 = ldsfrag(VBT, et0 * 16 + fr, P4, ks * 64 + fq * 16), b1 = ldsfrag(VBT, (et0 + 1) * 16 + fr, P4, ks * 64 + fq * 16);
                  qs0 = __builtin_amdgcn_mfma_f32_16x16x32_bf16(a, b0, qs0, 0, 0, 0); qs1 = __builtin_amdgcn_mfma_f32_16x16x32_bf16(a, b1, qs1, 0, 0, 0); }
#pragma unroll
              for (int jj = 0; jj < 4; ++jj) { bf16* op = O + (row0 + lt * 16 + fq * 4 + jj) * GD_VTOT + hv * 128 + half * 64 + et0 * 16 + fr; op[0] = bf1(qs0[jj]); op[16] = bf1(qs1[jj]); }
              const float dl = fexp(glast);
#pragma unroll
              for (int e = 0; e < 4; ++e) Sacc[e] = Sacc[e] * dl;
#pragma unroll
              for (int ks = 0; ks < 2; ++ks) { const bf16x8 a = ldsfrag(KUT, w * 16 + fr, P4, ks * 64 + fq * 16);
#pragma unroll
                  for (int e = 0; e < 4; ++e) { const bf16x8 bb = ldsfrag(VN2, e * 16 + fr, P4, ks * 64 + fq * 16); Sacc[e] = __builtin_amdgcn_mfma_f32_16x16x32_bf16(a, bb, Sacc[e], 0, 0, 0); } }
#pragma unroll
              for (int e = 0; e < 4; ++e) { v2u pk; pk.x = pk2(Sacc[e][0], Sacc[e][1]); pk.y = pk2(Sacc[e][2], Sacc[e][3]); *(LAS v2u*)(ST + (e * 16 + fr) * P8 + (w * 16 + fq * 4) * 2) = pk; } }
            __syncthreads();
        }
#undef GD_PREFETCH
    }
}

__device__ __forceinline__ void gdn_gate_phase(Frame& F, int j) {
    const int gw = blockIdx.x * NWAVES + F.wave, NGW = F.G * NWAVES;
    const bf16* S = (const bf16*)(F.ws + WS_SCAN); const bf16* P = (const bf16*)(F.ws + WS_PROJ); bf16* Yo = (bf16*)(F.ws + WS_YMIX);
    const int c8 = (F.lane & 15) * 8;
    const f32x4 g0 = *(const GAS f32x4*)(inp(F, I_GD_NG) + (size_t)j * 128 + c8), g1 = *(const GAS f32x4*)(inp(F, I_GD_NG) + (size_t)j * 128 + c8 + 4);
    const float g[8] = {g0.x, g0.y, g0.z, g0.w, g1.x, g1.y, g1.z, g1.w};
    for (int m = gw; m < M; m += NGW) {
#pragma unroll 2
        for (int ps = 0; ps < 8; ++ps) {
            const size_t col = (size_t)ps * 512 + F.lane * 8;
            const v4u sv = *(const GAS v4u*)(S + (size_t)m * GD_VTOT + col); const v4u zv = *(const GAS v4u*)(P + (size_t)m * GD_N + GD_CONVCH + col);
            const float a[8] = {bflo(sv.x), bfhi(sv.x), bflo(sv.y), bfhi(sv.y), bflo(sv.z), bfhi(sv.z), bflo(sv.w), bfhi(sv.w)};
            const float z[8] = {bflo(zv.x), bfhi(zv.x), bflo(zv.y), bfhi(zv.y), bflo(zv.z), bfhi(zv.z), bflo(zv.w), bfhi(zv.w)};
            float ss = 0.f;
#pragma unroll
            for (int i = 0; i < 8; ++i) ss += a[i] * a[i];
            ss += __shfl_xor(ss, 1); ss += __shfl_xor(ss, 2); ss += __shfl_xor(ss, 4); ss += __shfl_xor(ss, 8);
            const float rstd = __builtin_amdgcn_rsqf(ss * (1.0f / 128.0f) + EPS);
            float r[8];
#pragma unroll
            for (int i = 0; i < 8; ++i) r[i] = a[i] * rstd * g[i] * z[i] * fsigmoid(z[i]);
            v4u w; w.x = pk2(r[0], r[1]); w.y = pk2(r[2], r[3]); w.z = pk2(r[4], r[5]); w.w = pk2(r[6], r[7]);
            *(GAS v4u*)(Yo + (size_t)m * GD_VTOT + col) = w;
        }
    }
}

#ifndef REPG
#define REPG 1
#endif
#ifndef REPO
#define REPO 1
#endif
#ifndef REPP
#define REPP 1
#endif
#ifndef REPS
#define REPS 1
#endif
#ifndef REPS2
#define REPS2 1
#endif
struct Args { const float* in[15]; float* out; unsigned char* ws; };
__global__ void __launch_bounds__(NWAVES * 64, 2) mk_fwd(Args args) {
    extern __shared__ __attribute__((aligned(16))) unsigned char lds[];
    Frame F;
    F.lds = (LAS unsigned char*)lds;
    F.MISC = (volatile LAS unsigned*)(F.lds + MISC_OFF);
    F.tid = threadIdx.x; F.lane = F.tid & 63; F.wave = __builtin_amdgcn_readfirstlane(F.tid >> 6);
    F.G = gridDim.x;
    F.ws = args.ws; F.ctl = (gu32*)(args.ws + WS_CTL);
    F.out = args.out;
    for (int u = F.tid; u < (PTR_OFF - LDSCTL_OFF) / 4; u += NWAVES * 64) ((LAS unsigned*)(F.lds + LDSCTL_OFF))[u] = 0u;
    if (F.tid == 0) {
#pragma unroll
        for (int i = 0; i < 15; ++i) ((LAS unsigned long long*)(F.lds + PTR_OFF))[i] = (unsigned long long)args.in[i];
    }
    __syncthreads();
    XcdBarrier bar = xcd_barrier_post((unsigned*)(F.ctl + CW_BAR), F.MISC + 8);
#define GRID_BAR() xcd_barrier(bar)

    for (int rep_ = 0; rep_ < REPP; ++rep_) prologue(F);
    GRID_BAR(); relaunder(F);

    const pg8::bf16_t* HN = (const pg8::bf16_t*)(F.ws + WS_HN);
    for (int L = 0; L < DEPTH; ++L) {
        for (int s = 0; s < 2; ++s) {
            relaunder(F);
            { pg8::Gemm g{HN, (const pg8::bf16_t*)(F.ws + WS_W1 + (size_t)(2 * L + s) * SZ_W1), M, NFF1, D}; pg8::StaticOrder S; S.init(M, NFF1, F.G, (int)blockIdx.x);
              pg8::EpiSwiGLU E{(pg8::bf16_t*)(F.ws + WS_ACT), DFF};
              pg8::gemm_phase<pg8::EpiSwiGLU, pg8::StaticOrder, true, true>(F.lds + RING_OFF, g, S, E); if (REPG > 1) { __syncthreads(); pg8::gemm_phase<pg8::EpiSwiGLU, pg8::StaticOrder, true, true>(F.lds + RING_OFF, g, S, E); } }
            GRID_BAR(); relaunder(F);
            { pg8::Gemm g{(const pg8::bf16_t*)(F.ws + WS_ACT), (const pg8::bf16_t*)(F.ws + WS_W2 + (size_t)(2 * L + s) * SZ_W2), M, D, DFF}; pg8::StaticOrder S; S.init(M, D, F.G, (int)blockIdx.x);
              pg8::EpiBf16 E{(pg8::bf16_t*)(F.ws + WS_Y), D};
              pg8::gemm_phase<pg8::EpiBf16, pg8::StaticOrder, true, true>(F.lds + RING_OFF, g, S, E); if (REPG > 1) { __syncthreads(); pg8::gemm_phase<pg8::EpiBf16, pg8::StaticOrder, true, true>(F.lds + RING_OFF, g, S, E); } }
            GRID_BAR(); relaunder(F);
            if (s == 0) norm_phase(F, 0.5f, inp(F, I_NORMG) + (size_t)L * 6 * D + 1 * D, inp(F, I_NORMG) + (size_t)L * 6 * D + 2 * D, true);
            else        norm_phase(F, 0.5f, inp(F, I_NORMG) + (size_t)L * 6 * D + 5 * D, inp(F, I_NORMG) + (size_t)L * 6 * D + 6 * D, L + 1 < DEPTH);
            GRID_BAR(); relaunder(F);
            if (s == 0) {
                const int j = L >> 1;
                relaunder(F);
                if ((L & 1) == 0) {
                    for (int rep_ = 0; rep_ < REPO; ++rep_) skinny_phase<1>(F, (const bf16*)(F.ws + WS_MLX + (size_t)j * SZ_MLX), (float*)(F.ws + WS_GATES));
                    { pg8::Gemm g{HN, (const pg8::bf16_t*)(F.ws + WS_MLIN + (size_t)j * SZ_MLIN), M, ML_N, D}; pg8::StaticOrder S; S.init(M, ML_N, F.G, (int)blockIdx.x);
                      pg8::EpiBf16 E{(pg8::bf16_t*)(F.ws + WS_PROJ), ML_N};
                      pg8::gemm_phase<pg8::EpiBf16, pg8::StaticOrder, true, true>(F.lds + RING_OFF, g, S, E); if (REPG > 1) { __syncthreads(); pg8::gemm_phase<pg8::EpiBf16, pg8::StaticOrder, true, true>(F.lds + RING_OFF, g, S, E); } }
                    GRID_BAR(); relaunder(F);
                    for (int rep_ = 0; rep_ < REPS; ++rep_) ml_scan_fast(F, j);
                    GRID_BAR(); relaunder(F);
                    for (int rep_ = 0; rep_ < REPO; ++rep_) ml_gate_phase(F, j);
                    GRID_BAR(); relaunder(F);
                    { pg8::Gemm g{(const pg8::bf16_t*)(F.ws + WS_YMIX), (const pg8::bf16_t*)(F.ws + WS_MLOUT + (size_t)j * SZ_MLOUT), M, D, ML_V}; pg8::StaticOrder S; S.init(M, D, F.G, (int)blockIdx.x);
                      pg8::EpiBf16 E{(pg8::bf16_t*)(F.ws + WS_Y), D};
                      pg8::gemm_phase<pg8::EpiBf16, pg8::StaticOrder, true, true>(F.lds + RING_OFF, g, S, E); if (REPG > 1) { __syncthreads(); pg8::gemm_phase<pg8::EpiBf16, pg8::StaticOrder, true, true>(F.lds + RING_OFF, g, S, E); } }
                    GRID_BAR(); relaunder(F);
                } else {
                    for (int rep_ = 0; rep_ < REPO; ++rep_) skinny_phase<4>(F, (const bf16*)(F.ws + WS_GDX + (size_t)j * SZ_GDX), (float*)(F.ws + WS_GATES));
                    { pg8::Gemm g{HN, (const pg8::bf16_t*)(F.ws + WS_GDIN + (size_t)j * SZ_GDIN), M, GD_N, D}; pg8::StaticOrder S; S.init(M, GD_N, F.G, (int)blockIdx.x);
                      pg8::EpiBf16 E{(pg8::bf16_t*)(F.ws + WS_PROJ), GD_N};
                      pg8::gemm_phase<pg8::EpiBf16, pg8::StaticOrder, true, true>(F.lds + RING_OFF, g, S, E); if (REPG > 1) { __syncthreads(); pg8::gemm_phase<pg8::EpiBf16, pg8::StaticOrder, true, true>(F.lds + RING_OFF, g, S, E); } }
                    GRID_BAR(); relaunder(F);
                    for (int rep_ = 0; rep_ < REPS2; ++rep_) gdn_scan_fast(F, j);
                    GRID_BAR(); relaunder(F);
                    for (int rep_ = 0; rep_ < REPO; ++rep_) gdn_gate_phase(F, j);
                    GRID_BAR(); relaunder(F);
                    { pg8::Gemm g{(const pg8::bf16_t*)(F.ws + WS_YMIX), (const pg8::bf16_t*)(F.ws + WS_GDOUT + (size_t)j * SZ_GDOUT), M, D, GD_VTOT}; pg8::StaticOrder S; S.init(M, D, F.G, (int)blockIdx.x);
                      pg8::EpiBf16 E{(pg8::bf16_t*)(F.ws + WS_Y), D};
                      pg8::gemm_phase<pg8::EpiBf16, pg8::StaticOrder, true, true>(F.lds + RING_OFF, g, S, E); if (REPG > 1) { __syncthreads(); pg8::gemm_phase<pg8::EpiBf16, pg8::StaticOrder, true, true>(F.lds + RING_OFF, g, S, E); } }
                    GRID_BAR(); relaunder(F);
                }
                norm_phase(F, 1.0f, inp(F, I_NORMG) + (size_t)L * 6 * D + 3 * D, inp(F, I_NORMG) + (size_t)L * 6 * D + 4 * D, true);
                GRID_BAR(); relaunder(F);
            }
        }
    }
}

extern "C" void kernel_launch(void* const* d_in, const int* in_sizes, int n_in, void* d_out, int out_size, void* d_ws, size_t ws_size, hipStream_t stream) {
    static int grid = 0;
    if (grid == 0) {
        if (n_in != 15 || in_sizes[0] != M * D || out_size != M * D || ws_size < WS_END) { fprintf(stderr, "kernel_launch: unexpected shapes (n_in %d, in0 %d, out %d, ws %zu < %zu); nothing launched\n", n_in, n_in > 0 ? in_sizes[0] : -1, out_size, ws_size, (size_t)WS_END); grid = -1; return; }
        int dev = 0, cus = 0, per_cu = 0;
        if (hipGetDevice(&dev) != hipSuccess || hipDeviceGetAttribute(&cus, hipDeviceAttributeMultiprocessorCount, dev) != hipSuccess) { grid = -1; return; }
        if (hipFuncSetAttribute((const void*)mk_fwd, hipFuncAttributeMaxDynamicSharedMemorySize, LDS_BYTES) != hipSuccess) { fprintf(stderr, "kernel_launch: hipFuncSetAttribute failed\n"); grid = -1; return; }
        if (hipOccupancyMaxActiveBlocksPerMultiprocessor(&per_cu, (const void*)mk_fwd, NWAVES * 64, LDS_BYTES) != hipSuccess || per_cu < 1) { fprintf(stderr, "kernel_launch: occupancy query says %d\n", per_cu); (void)hipGetLastError(); grid = -1; return; }
        (void)hipGetLastError();
        grid = cus;
    }
    if (grid < 0) return;
    if (hipMemsetAsync((char*)d_ws + WS_CTL, 0, CTL_ZERO_BYTES, stream) != hipSuccess) return;
    Args a{};
    for (int i = 0; i < 15; ++i) a.in[i] = (const float*)d_in[i];
    a.out = (float*)d_out; a.ws = (unsigned char*)d_ws;
    hipLaunchKernelGGL(mk_fwd, dim3(grid), dim3(NWAVES * 64), LDS_BYTES, stream, a);
}
```
